# Optimizing an MI355X kernel written in HIP

```python
import math
import numpy as np
import jax
import jax.numpy as jnp
from jax import lax

D_MODEL = 2048
BATCH = 4
SEQ = 4096
DEPTH = 2

CTX_LEN = 256
GRID_W = 64

MIX = D_MODEL
N_GROUPS = 4
GROUP = MIX // N_GROUPS
CHUNK = 64
EPS = 1e-6

GLA_HEADS = 4
GLA_DV = GROUP // GLA_HEADS
GLA_DK = GLA_DV // 2
GLA_LR = 16
GLA_TAU = 16.0

GDN_HEADS = 4
GDN_DK = GROUP // GDN_HEADS
GDN_DV = GDN_DK
CONV_W = 3

RW_HEAD = 64
RW_HEADS = GROUP // RW_HEAD
RW_DECAY_LR = 32
RW_A_LR = 32
RW_GATE_LR = 96
RW_DECAY_SCALE = math.exp(-0.5)
RW_GN_EPS = 64e-5

FFN = -(-(8 * D_MODEL) // (3 * 256)) * 256

PROJ_WIDTHS = (
    GLA_HEADS * GLA_DK, GLA_HEADS * GLA_DK, GROUP, GROUP, GLA_LR,
    3 * GROUP, GROUP, 2 * GDN_HEADS, 2 * GDN_HEADS,
    GROUP, GROUP, GROUP,
    3 * GROUP, RW_DECAY_LR + RW_A_LR, RW_GATE_LR,
)
PROJ = sum(PROJ_WIDTHS)

kernel_name = 'hybrid_parallel_groups_flow_block'


def _rmsnorm(x, g):
    xf = x.astype(jnp.float32)
    y = xf * lax.rsqrt(jnp.mean(xf * xf, axis=-1, keepdims=True) + EPS)
    return (y * g.astype(jnp.float32)).astype(x.dtype)


def _rms_heads(o, g):
    return o * lax.rsqrt(jnp.mean(o * o, axis=-1, keepdims=True) + EPS) * g


def _group_norm(y, w, bias):
    mu = jnp.mean(y, axis=-1, keepdims=True)
    var = jnp.mean(jnp.square(y - mu), axis=-1, keepdims=True)
    yn = (y - mu) * lax.rsqrt(var + RW_GN_EPS)
    return yn.reshape(y.shape[:-2] + (-1,)) * w + bias


def _l2norm(x):
    return x * lax.rsqrt(jnp.sum(x * x, axis=-1, keepdims=True) + EPS)


def _heads(t, n_heads):
    return t.reshape(t.shape[:-1] + (n_heads, t.shape[-1] // n_heads))


def _flip(t):
    return jnp.flip(t, axis=1)


def _to_chunks(t):
    return t.reshape((t.shape[0], t.shape[1] // CHUNK, CHUNK) + t.shape[2:])


def _conv3_rows(x, w, row_len):
    b, t, ch = x.shape
    rows = t // row_len
    xp = jnp.pad(x.reshape(b, rows, row_len, ch), ((0, 0), (0, 0), (1, 1), (0, 0)))
    y = xp[:, :, :-2] * w[0] + xp[:, :, 1:-1] * w[1] + xp[:, :, 2:] * w[2]
    return y.reshape(b, t, ch)


def _token_shift(x, mu):
    prev = jnp.pad(x, ((0, 0), (1, 0), (0, 0)))[:, :-1]
    return x + (prev - x) * mu


def _gla_scan(q, k, v, log_f, s0):
    b, t, h, dv = v.shape
    q, k, v, log_f = (_to_chunks(a) for a in (q, k, v, log_f))
    cum = jnp.cumsum(log_f, axis=2)
    last = cum[:, :, -1:]
    q_dec = q * jnp.exp(cum)
    k_inv = k * jnp.exp(-cum)
    k_end = k * jnp.exp(last - cum)
    lower = jnp.tril(jnp.ones((CHUNK, CHUNK), bool))
    att = jnp.where(lower, jnp.einsum('bnihd,bnjhd->bnhij', q_dec, k_inv), 0.0)
    o_intra = jnp.einsum('bnhij,bnjhv->bnihv', att, v)
    d_state = jnp.einsum('bnjhd,bnjhv->nbhdv', k_end, v)
    chunk_decay = jnp.moveaxis(jnp.exp(last[:, :, 0]), 1, 0)

    def step(s, inp):
        dec, ds = inp
        return dec[..., None] * s + ds, s

    s_fin, s_start = lax.scan(step, s0, (chunk_decay, d_state))
    o_inter = jnp.einsum('bnihd,nbhdv->bnihv', q_dec, s_start)
    return (o_intra + o_inter).reshape(b, t, h, dv), s_fin


def _gdn_scan(q, k, v, log_a, beta, s0):
    b, t, h, dv = v.shape
    dk = q.shape[-1]
    hm = lambda a: jnp.moveaxis(_to_chunks(a), 3, 2)
    q, k, v, log_a, beta = (hm(a) for a in (q, k, v, log_a, beta))
    q = q * dk ** -0.5
    cum = jnp.cumsum(log_a, axis=-1)
    lower = jnp.tril(jnp.ones((CHUNK, CHUNK), bool))
    strict = jnp.tril(jnp.ones((CHUNK, CHUNK), bool), -1)
    decay = jnp.exp(jnp.where(lower, cum[..., :, None] - cum[..., None, :], -jnp.inf))
    kk = jnp.einsum('bnhid,bnhjd->bnhij', k, k)
    lmat = jnp.where(strict, beta[..., None] * kk * decay, 0.0) + jnp.eye(CHUNK, dtype=kk.dtype)
    rhs = jnp.concatenate([v * beta[..., None], k * (beta * jnp.exp(cum))[..., None]], axis=-1)
    sol = lax.linalg.triangular_solve(lmat, rhs, left_side=True, lower=True, unit_diagonal=True)
    u, w = sol[..., :dv], sol[..., dv:]
    a_qk = jnp.einsum('bnhid,bnhjd->bnhij', q, k) * decay
    k_end = k * jnp.exp(cum[..., -1:] - cum)[..., None]
    chunk_decay = jnp.exp(cum[..., -1])
    cm = lambda a: jnp.moveaxis(a, 1, 0)

    def step(s, inp):
        u_i, w_i, ke_i, dec_i = inp
        v_new = u_i - jnp.einsum('bhcd,bhdv->bhcv', w_i, s)
        s_next = dec_i[..., None, None] * s + jnp.einsum('bhcd,bhcv->bhdv', ke_i, v_new)
        return s_next, (s, v_new)

    s_fin, (s_start, v_new) = lax.scan(step, s0, (cm(u), cm(w), cm(k_end), cm(chunk_decay)))
    o = (jnp.einsum('bnhcd,nbhdv->bnhcv', q * jnp.exp(cum)[..., None], s_start)
         + jnp.einsum('bnhij,nbhjv->bnhiv', a_qk, v_new))
    return jnp.moveaxis(o, 2, 3).reshape(b, t, h, dv), s_fin


def _rwkv7_scan(r, w, k, v, kk, a, s0):
    tm = lambda t: jnp.moveaxis(t, 1, 0)

    def step(s, inp):
        r_t, w_t, k_t, v_t, kk_t, a_t = inp
        sa = jnp.einsum('bhvk,bhk->bhv', s, kk_t)
        s = (s * w_t[:, :, None, :] - sa[..., None] * (kk_t * a_t)[:, :, None, :]
             + v_t[..., None] * k_t[:, :, None, :])
        return s, jnp.einsum('bhvk,bhk->bhv', s, r_t)

    s_fin, y = lax.scan(step, s0, tuple(tm(t) for t in (r, w, k, v, kk, a)))
    return tm(y), s_fin


def _rwkv7_direction(p_rkv, p_wa, s0, mu_rkv, mu_wa, w0, w2, a0, a2, k_k, k_a, r_k):
    x_rkv = _token_shift(p_rkv, mu_rkv)
    x_wa = _token_shift(p_wa, mu_wa)
    r, k, v = jnp.split(x_rkv, 3, axis=-1)
    w_lo, a_lo = jnp.split(x_wa, [RW_DECAY_LR], axis=-1)
    decay = jnp.exp(-RW_DECAY_SCALE * jax.nn.sigmoid(w0 + jnp.tanh(w_lo) @ w2))
    a = jax.nn.sigmoid(a0 + a_lo @ a2)
    kk = _l2norm(_heads(k * k_k, RW_HEADS))
    k = k * (1.0 + (a - 1.0) * k_a)
    r, k, v, a, decay = (_heads(t, RW_HEADS) for t in (r, k, v, a, decay))
    y, s_fin = _rwkv7_scan(r, decay, k, v, kk, a, s0)
    bonus = jnp.sum(r * k * r_k, axis=-1, keepdims=True) * v
    return y, bonus, s_fin


def _mix(n, row_len, init, lp):
    b, t, _ = n.shape
    offs = tuple(int(o) for o in np.cumsum(PROJ_WIDTHS)[:-1])
    (g_q, g_k, g_v, g_r, g_lo, d_qkv, d_z, d_a, d_b, c_b, c_c, c_h, r_rkv, r_wa, r_g) = jnp.split(
        (n @ lp['w_in']).astype(jnp.float32), offs, axis=-1)

    q = _heads(g_q, GLA_HEADS) * GLA_DK ** -0.5
    k = _heads(g_k, GLA_HEADS)
    v = _heads(g_v, GLA_HEADS)
    log_f = [_heads(jax.nn.log_sigmoid(g_lo @ lp['gla_a_up'][i] + lp['gla_a_b'][i]) / GLA_TAU, GLA_HEADS)
             for i in range(2)]
    o_f, s_gla_f = _gla_scan(q, k, v, log_f[0], init[0])
    o_b, s_gla_b = _gla_scan(_flip(q), _flip(k), _flip(v), _flip(log_f[1]), init[1])
    y_gla = _rms_heads(o_f + _flip(o_b), lp['gla_norm_g']) * jax.nn.silu(_heads(g_r, GLA_HEADS))

    qkv = jax.nn.silu(_conv3_rows(d_qkv, lp['gdn_conv'], row_len))
    q, k, v = (_heads(a, GDN_HEADS) for a in jnp.split(qkv, 3, axis=-1))
    q, k = _l2norm(q), _l2norm(k)
    log_a = -jnp.exp(lp['gdn_a_log']) * jax.nn.softplus(d_a.reshape(b, t, 2, GDN_HEADS) + lp['gdn_dt_bias'])
    beta = jax.nn.sigmoid(d_b.reshape(b, t, 2, GDN_HEADS))
    o_f, s_gdn_f = _gdn_scan(q, k, v, log_a[:, :, 0], beta[:, :, 0], init[2])
    o_b, s_gdn_b = _gdn_scan(_flip(q), _flip(k), _flip(v), _flip(log_a[:, :, 1]), _flip(beta[:, :, 1]), init[3])
    y_gdn = _rms_heads(o_f + _flip(o_b), lp['gdn_norm_g']) * jax.nn.silu(_heads(d_z, GDN_HEADS))

    y_sc = c_b * _conv3_rows(c_c * c_h, lp['sc_conv'], row_len)

    def dir_args(i):
        return (lp['rw_mu_rkv'][i], lp['rw_mu_wa'][i], lp['rw_w0'][i], lp['rw_w2'][i],
                lp['rw_a0'][i], lp['rw_a2'][i], lp['rw_kk'], lp['rw_ka'], lp['rw_rk'])
    y_f, bo_f, s_rw_f = _rwkv7_direction(r_rkv, r_wa, init[4], *dir_args(0))
    y_b, bo_b, s_rw_b = _rwkv7_direction(_flip(r_rkv), _flip(r_wa), init[5], *dir_args(1))
    y_rw = (_group_norm(y_f + _flip(y_b), lp['rw_gn_w'], lp['rw_gn_b'])
            + (bo_f + _flip(bo_b)).reshape(b, t, GROUP))
    y_rw = y_rw * (jax.nn.sigmoid(r_g) @ lp['rw_g2'])

    y = jnp.concatenate([y_gla.reshape(b, t, GROUP), y_gdn.reshape(b, t, GROUP), y_sc, y_rw],
                        axis=-1).astype(n.dtype)
    return y @ lp['w_out'], (s_gla_f, s_gla_b, s_gdn_f, s_gdn_b, s_rw_f, s_rw_b)


def _modulation(cond, w, bias):
    m = jax.nn.silu(cond) @ w + bias
    return [a[:, None, :] for a in jnp.split(m, 6, axis=-1)]


def _modnorm(h, g, shift, scale):
    return _rmsnorm(h, g) * (1.0 + scale) + shift


def _swiglu(h, w_gu, w_down):
    gate, up = jnp.split(h @ w_gu, 2, axis=-1)
    return (jax.nn.silu(gate) * up) @ w_down


def _zero_states(b):
    z = lambda h, d1, d2: jnp.zeros((b, h, d1, d2), jnp.float32)
    return (z(GLA_HEADS, GLA_DK, GLA_DV), z(GLA_HEADS, GLA_DK, GLA_DV),
            z(GDN_HEADS, GDN_DK, GDN_DV), z(GDN_HEADS, GDN_DK, GDN_DV),
            z(RW_HEADS, RW_HEAD, RW_HEAD), z(RW_HEADS, RW_HEAD, RW_HEAD))


def setup_inputs(seed: int = 0) -> dict:
    key = jax.random.key(seed)
    keys = iter(jax.random.split(key, 48))

    def nrm(shape, std):
        return std * jax.random.normal(next(keys), shape, jnp.float32)

    def uni(shape, lo, hi):
        return jax.random.uniform(next(keys), shape, jnp.float32, lo, hi)

    L, D = DEPTH, D_MODEL
    dt = jnp.exp(uni((L, 2, GDN_HEADS), math.log(1e-3), math.log(1e-1)))
    return {
        'x': nrm((BATCH, SEQ, D), 1.0),
        'c': nrm((BATCH, D), 1.0),
        'ctx': nrm((BATCH, CTX_LEN, D), 1.0),
        'c_ctx': nrm((D,), 1.0),
        'ada_w': nrm((L, D, 6 * D), 0.5 * D ** -0.5),
        'ada_b': nrm((L, 6 * D), 0.02),
        'norm1_g': 1.0 + nrm((L, D), 0.02),
        'norm2_g': 1.0 + nrm((L, D), 0.02),
        'w_in': nrm((L, D, PROJ), D ** -0.5),
        'w_out': nrm((L, MIX, D), MIX ** -0.5),
        'gla_a_up': nrm((L, 2, GLA_LR, GLA_HEADS * GLA_DK), GLA_LR ** -0.5),
        'gla_a_b': nrm((L, 2, GLA_HEADS * GLA_DK), 0.5),
        'gla_norm_g': 1.0 + nrm((L, GLA_DV), 0.02),
        'gdn_conv': nrm((L, CONV_W, 3 * GROUP), 0.5),
        'gdn_a_log': jnp.log(uni((L, 2, GDN_HEADS), 1.0, 16.0)),
        'gdn_dt_bias': dt + jnp.log(-jnp.expm1(-dt)),
        'gdn_norm_g': 1.0 + nrm((L, GDN_DV), 0.02),
        'sc_conv': nrm((L, CONV_W, GROUP), 0.5),
        'rw_mu_rkv': uni((L, 2, 3 * GROUP), 0.0, 1.0),
        'rw_mu_wa': uni((L, 2, RW_DECAY_LR + RW_A_LR), 0.0, 1.0),
        'rw_w0': uni((L, 2, GROUP), -2.0, 2.0),
        'rw_w2': nrm((L, 2, RW_DECAY_LR, GROUP), RW_DECAY_LR ** -0.5),
        'rw_a0': nrm((L, 2, GROUP), 0.5),
        'rw_a2': nrm((L, 2, RW_A_LR, GROUP), RW_A_LR ** -0.5),
        'rw_g2': nrm((L, RW_GATE_LR, GROUP), RW_GATE_LR ** -0.5),
        'rw_kk': 0.85 + nrm((L, GROUP), 0.02),
        'rw_ka': 1.0 + nrm((L, GROUP), 0.02),
        'rw_rk': nrm((L, RW_HEADS, RW_HEAD), 0.1),
        'rw_gn_w': 1.0 + nrm((L, GROUP), 0.02),
        'rw_gn_b': nrm((L, GROUP), 0.02),
        'ffn_w_gu': nrm((L, D, 2 * FFN), D ** -0.5),
        'ffn_w_down': nrm((L, FFN, D), FFN ** -0.5),
        'final_g': 1.0 + nrm((D,), 0.02),
    }


def reference(x, c, ctx, c_ctx, ada_w, ada_b, norm1_g, norm2_g, w_in, w_out,
              gla_a_up, gla_a_b, gla_norm_g, gdn_conv, gdn_a_log, gdn_dt_bias, gdn_norm_g,
              sc_conv, rw_mu_rkv, rw_mu_wa, rw_w0, rw_w2, rw_a0, rw_a2, rw_g2, rw_kk, rw_ka,
              rw_rk, rw_gn_w, rw_gn_b, ffn_w_gu, ffn_w_down, final_g):
    h_x, h_c = x, ctx
    zero = _zero_states(x.shape[0])
    for l in range(DEPTH):
        lp = dict(w_in=w_in[l], w_out=w_out[l], gla_a_up=gla_a_up[l], gla_a_b=gla_a_b[l],
                  gla_norm_g=gla_norm_g[l], gdn_conv=gdn_conv[l], gdn_a_log=gdn_a_log[l],
                  gdn_dt_bias=gdn_dt_bias[l], gdn_norm_g=gdn_norm_g[l], sc_conv=sc_conv[l],
                  rw_mu_rkv=rw_mu_rkv[l], rw_mu_wa=rw_mu_wa[l], rw_w0=rw_w0[l], rw_w2=rw_w2[l],
                  rw_a0=rw_a0[l], rw_a2=rw_a2[l], rw_g2=rw_g2[l], rw_kk=rw_kk[l], rw_ka=rw_ka[l],
                  rw_rk=rw_rk[l], rw_gn_w=rw_gn_w[l], rw_gn_b=rw_gn_b[l])
        m_x = _modulation(c, ada_w[l], ada_b[l])
        m_c = _modulation(c_ctx[None, :], ada_w[l], ada_b[l])
        o_c, ctx_states = _mix(_modnorm(h_c, norm1_g[l], m_c[0], m_c[1]), h_c.shape[1], zero, lp)
        o_x, _ = _mix(_modnorm(h_x, norm1_g[l], m_x[0], m_x[1]), GRID_W, ctx_states, lp)
        h_x = h_x + m_x[2] * o_x
        h_x = h_x + m_x[5] * _swiglu(_modnorm(h_x, norm2_g[l], m_x[3], m_x[4]), ffn_w_gu[l], ffn_w_down[l])
        if l < DEPTH - 1:
            h_c = h_c + m_c[2] * o_c
            h_c = h_c + m_c[5] * _swiglu(_modnorm(h_c, norm2_g[l], m_c[3], m_c[4]), ffn_w_gu[l], ffn_w_down[l])
    return _rmsnorm(h_x, final_g)
```

```cpp
#include <hip/hip_runtime.h>
#include <hip/hip_bf16.h>
#include <hip/hip_cooperative_groups.h>
#include <cstdio>
namespace cg = cooperative_groups;
typedef unsigned short u16;
using bf16x8 = __attribute__((ext_vector_type(8))) short;
using f32x4 = __attribute__((ext_vector_type(4))) float;

#ifndef PROBE_NSTEP
#define PROBE_NSTEP 1
#endif
#ifndef PROBE_NPREP
#define PROBE_NPREP 1
#endif
#ifndef PROBE_NSTEP_RW
#define PROBE_NSTEP_RW PROBE_NSTEP
#endif
#ifndef PROBE_NPREP_RW
#define PROBE_NPREP_RW PROBE_NPREP
#endif
#ifndef MEGA
#define MEGA 1
#endif

constexpr int D = 2048, NB = 4, SEQ = 4096, CTX = 256;
constexpr int NX = NB * SEQ, NC = NB * CTX, NT = NX + NC;
constexpr int PROJ = 6848, PROJP = 6912, FFN = 5632;
constexpr int O_GQ = 0, O_GK = 256, O_GV = 512, O_GR = 1024, O_GLO = 1536;
constexpr int O_DQKV = 1552, O_DZ = 3088, O_DA = 3600, O_DB = 3608;
constexpr int O_CB = 3616, O_CC = 4128, O_CH = 4640;
constexpr int O_RKV = 5152, O_RWA = 6688, O_RG = 6752;
constexpr int NTHR = 512;
constexpr int SHM_BYTES = 131072;
constexpr int TC = 32;

struct P {
  const float *x, *c, *ctx, *c_ctx, *ada_w, *ada_b, *norm1_g, *norm2_g, *w_in, *w_out,
      *gla_a_up, *gla_a_b, *gla_norm_g, *gdn_conv, *gdn_a_log, *gdn_dt_bias, *gdn_norm_g, *sc_conv,
      *rw_mu_rkv, *rw_mu_wa, *rw_w0, *rw_w2, *rw_a0, *rw_a2, *rw_g2, *rw_kk, *rw_ka, *rw_rk,
      *rw_gn_w, *rw_gn_b, *ffn_w_gu, *ffn_w_down, *final_g;
  float* out;
  u16 *wt_in, *wt_out, *wt_gu, *wt_down, *nbuf, *projb;
  float *mod, *hc, *osc, *sbon;
  unsigned* bar;
  float *rwd, *rwa;
  float *kqa;
  float *glf, *gab;
};

__device__ __forceinline__ float bf2f(u16 v) { return __uint_as_float(((unsigned)v) << 16); }
__device__ __forceinline__ u16 f2bf(float f) {
  unsigned u = __float_as_uint(f);
  u += 0x7fffu + ((u >> 16) & 1u);
  return (u16)(u >> 16);
}
__device__ __forceinline__ float sigmoidf_(float x) { return 1.f / (1.f + __expf(-x)); }
__device__ __forceinline__ float siluf_(float x) { return x / (1.f + __expf(-x)); }
__device__ __forceinline__ float tanhf_(float x) { return 1.f - 2.f / (1.f + __expf(2.f * x)); }
__device__ __forceinline__ float softplusf_(float x) { return fmaxf(x, 0.f) + log1pf(__expf(-fabsf(x))); }
template <int CTRL> __device__ __forceinline__ float dpp_f(float v) {
  return __int_as_float(__builtin_amdgcn_mov_dpp(__float_as_int(v), CTRL, 0xf, 0xf, true));
}
__device__ __forceinline__ float red8(float v) {
  v += dpp_f<0xB1>(v); v += dpp_f<0x4E>(v); v += dpp_f<0x141>(v); return v;
}
__device__ __forceinline__ float red16(float v) { v = red8(v); v += dpp_f<0x140>(v); return v; }
__device__ __forceinline__ float wave_sum(float v) {
  v = red16(v); v += __shfl_xor(v, 16); v += __shfl_xor(v, 32); return v;
}
__device__ __forceinline__ float rdlane(float v, int l) {
  return __int_as_float(__builtin_amdgcn_readlane(__float_as_int(v), l));
}
__device__ __forceinline__ int tokrow(int seq, int b, int t) { return seq ? (b * SEQ + t) : (NX + b * CTX + t); }
__device__ __forceinline__ int condof(int row) { return row < NX ? (row >> 12) : 4; }
__device__ __forceinline__ int TIDX() { int t = threadIdx.x; asm volatile("" : "+v"(t)); return t; }

#define LBAR() do { asm volatile("s_waitcnt lgkmcnt(0)" ::: "memory"); __builtin_amdgcn_s_barrier(); asm volatile("" ::: "memory"); } while (0)

__device__ void phase_mod(const P& p, float* lds) {
  float* scond = lds;
  float* red = lds + 5 * D;
  const int tid = TIDX();
  for (int e = tid; e < 5 * D; e += NTHR) {
    int cnd = e / D, k = e % D;
    float v = cnd < 4 ? p.c[cnd * D + k] : p.c_ctx[k];
    scond[e] = siluf_(v);
  }
  __syncthreads();
  const int c4 = tid & 31, kg = tid >> 5;
  for (int tile = blockIdx.x; tile < 2 * 96; tile += gridDim.x) {
    int l = tile / 96, n0 = (tile % 96) * 128;
    float acc[5][4];
#pragma unroll
    for (int a = 0; a < 5; ++a)
#pragma unroll
      for (int j = 0; j < 4; ++j) acc[a][j] = 0.f;
    const float* W = p.ada_w + (size_t)l * D * 6 * D + n0 + c4 * 4;
#pragma unroll 4
    for (int i = 0; i < 128; ++i) {
      int k = kg + 16 * i;
      f32x4 wv_ = __builtin_nontemporal_load(reinterpret_cast<const f32x4*>(W + (size_t)k * 6 * D));
      float4 w = make_float4(wv_[0], wv_[1], wv_[2], wv_[3]);
#pragma unroll
      for (int a = 0; a < 5; ++a) {
        float s = scond[a * D + k];
        acc[a][0] += s * w.x; acc[a][1] += s * w.y; acc[a][2] += s * w.z; acc[a][3] += s * w.w;
      }
    }
#pragma unroll
    for (int a = 0; a < 5; ++a)
#pragma unroll
      for (int j = 0; j < 4; ++j) red[(kg * 5 + a) * 128 + c4 * 4 + j] = acc[a][j];
    __syncthreads();
    for (int e = tid; e < 5 * 128; e += NTHR) {
      int a = e / 128, cc = e % 128;
      float s = 0.f;
#pragma unroll
      for (int g = 0; g < 16; ++g) s += red[(g * 5 + a) * 128 + cc];
      p.mod[((size_t)l * 5 + a) * 6 * D + n0 + cc] = s + p.ada_b[(size_t)l * 6 * D + n0 + cc];
    }
    __syncthreads();
  }
}

template <int MAP>
__device__ void conv_tiles(const float* src, int K, int Nsrc, u16* dst, int Ndst, float* lds, int& cursor, int vblk, int nblk_total) {
  const int tid = TIDX();
  const int nkt = K / 64, nnt = Ndst / 64, ntile = nkt * nnt;
  float* tile = lds;
  const int kr = tid >> 4, c4 = tid & 15;
  const int n = tid >> 3, kc = tid & 7;
  int first = (vblk - cursor % nblk_total + nblk_total) % nblk_total;
  float4 v0 = make_float4(0.f, 0.f, 0.f, 0.f), v1 = v0;
#define CONV_LOAD(TI, A0, A1) do { \
    int kt_ = (TI) % nkt, nt_ = (TI) / nkt; \
    int nd_ = nt_ * 64 + c4 * 4, ns_; bool valid_ = true; \
    if (MAP == 0) ns_ = nd_; \
    else if (MAP == 1) { valid_ = nd_ < PROJ; ns_ = valid_ ? nd_ : 0; } \
    else { int pn_ = nd_ >> 8, r_ = nd_ & 255; ns_ = (r_ >> 7) * FFN + pn_ * 128 + (r_ & 127); } \
    const float* s_ = src + (size_t)(kt_ * 64 + kr) * Nsrc + ns_; \
    { f32x4 t0_ = __builtin_nontemporal_load(reinterpret_cast<const f32x4*>(s_)), t1_ = __builtin_nontemporal_load(reinterpret_cast<const f32x4*>(s_ + (size_t)32 * Nsrc)); \
      A0 = make_float4(t0_[0], t0_[1], t0_[2], t0_[3]); A1 = make_float4(t1_[0], t1_[1], t1_[2], t1_[3]); } \
    if (MAP == 1 && !valid_) { A0 = make_float4(0.f, 0.f, 0.f, 0.f); A1 = A0; } } while (0)
  if (first < ntile) CONV_LOAD(first, v0, v1);
  for (int tI = first; tI < ntile; tI += nblk_total) {
    int kt = tI % nkt, nt = tI / nkt;
    int k0 = kt * 64, n0 = nt * 64;
    tile[kr * 65 + c4 * 4 + 0] = v0.x; tile[kr * 65 + c4 * 4 + 1] = v0.y; tile[kr * 65 + c4 * 4 + 2] = v0.z; tile[kr * 65 + c4 * 4 + 3] = v0.w;
    tile[(kr + 32) * 65 + c4 * 4 + 0] = v1.x; tile[(kr + 32) * 65 + c4 * 4 + 1] = v1.y; tile[(kr + 32) * 65 + c4 * 4 + 2] = v1.z; tile[(kr + 32) * 65 + c4 * 4 + 3] = v1.w;
    if (tI + nblk_total < ntile) CONV_LOAD(tI + nblk_total, v0, v1);
    LBAR();
    {
      bf16x8 o;
#pragma unroll
      for (int j = 0; j < 8; ++j) o[j] = (short)f2bf(tile[(kc * 8 + j) * 65 + n]);
      *reinterpret_cast<bf16x8*>(dst + (size_t)(n0 + n) * K + k0 + kc * 8) = o;
    }
    LBAR();
  }
#undef CONV_LOAD
  cursor += ntile;
}
__device__ void phase_convert(const P& p, int l, float* lds, int vblk, int nb) {
  int cursor = 0;
  u16* wi = p.wt_in; u16* wo = p.wt_out; u16* wg = p.wt_gu; u16* wd = p.wt_down;
  conv_tiles<1>(p.w_in + (size_t)l * D * PROJ, D, PROJ, wi, PROJP, lds, cursor, vblk, nb);
  conv_tiles<0>(p.w_out + (size_t)l * D * D, D, D, wo, D, lds, cursor, vblk, nb);
  conv_tiles<2>(p.ffn_w_gu + (size_t)l * D * 2 * FFN, D, 2 * FFN, wg, 2 * FFN, lds, cursor, vblk, nb);
  conv_tiles<0>(p.ffn_w_down + (size_t)l * FFN * D, FFN, D, wd, D, lds, cursor, vblk, nb);
}

__device__ void phase_norm(const P& p, int l, int which, int ntok) {
  const int tid = TIDX(), lane = tid & 63, wv = tid >> 6;
  const int gw = blockIdx.x * 8 + wv, nw = gridDim.x * 8;
  const int per = (ntok + nw - 1) / nw;
  const int rbeg = gw * per, rend = min(ntok, rbeg + per);
  if (rbeg >= rend) return;
  const bool first_in = (l == 0 && which == 0);
  auto rowsrc = [&](int row) -> const float* {
    if (row < NX) return first_in ? p.x + (size_t)row * D : p.out + (size_t)row * D;
    return first_in ? p.ctx + (size_t)(row - NX) * D : p.hc + (size_t)(row - NX) * D;
  };
  float4 gs[8], hh[8];
  int cur_cond = -1;
  float4 v[8], vn[8];
  {
    const float* s0 = rowsrc(rbeg);
#pragma unroll
    for (int i = 0; i < 8; ++i) vn[i] = *reinterpret_cast<const float4*>(s0 + i * 256 + lane * 4);
  }
#pragma unroll 1
  for (int row = rbeg; row < rend; ++row) {
#pragma unroll
    for (int i = 0; i < 8; ++i) v[i] = vn[i];
    if (row + 1 < rend) {
      const float* s1 = rowsrc(row + 1);
#pragma unroll
      for (int i = 0; i < 8; ++i) vn[i] = *reinterpret_cast<const float4*>(s1 + i * 256 + lane * 4);
    }
    const int cnd = which == 2 ? 0 : condof(row);
    if (cnd != cur_cond) {
      cur_cond = cnd;
      if (which == 2) {
#pragma unroll
        for (int i = 0; i < 8; ++i) { gs[i] = *reinterpret_cast<const float4*>(p.final_g + i * 256 + lane * 4); hh[i] = make_float4(0.f, 0.f, 0.f, 0.f); }
      } else {
        const float* gg = (which == 0 ? p.norm1_g : p.norm2_g) + (size_t)l * D;
        const float* md = p.mod + ((size_t)l * 5 + cnd) * 6 * D;
        const float* sh = md + (which == 0 ? 0 : 3) * D;
        const float* sc = md + (which == 0 ? 1 : 4) * D;
#pragma unroll
        for (int i = 0; i < 8; ++i) {
          int cc = i * 256 + lane * 4;
          float4 g = *reinterpret_cast<const float4*>(gg + cc);
          float4 s = *reinterpret_cast<const float4*>(sc + cc);
          hh[i] = *reinterpret_cast<const float4*>(sh + cc);
          gs[i] = make_float4(g.x * (1.f + s.x), g.y * (1.f + s.y), g.z * (1.f + s.z), g.w * (1.f + s.w));
        }
      }
    }
    float ss = 0.f;
#pragma unroll
    for (int i = 0; i < 8; ++i) ss += v[i].x * v[i].x + v[i].y * v[i].y + v[i].z * v[i].z + v[i].w * v[i].w;
    ss = wave_sum(ss);
    float rstd = rsqrtf(ss * (1.f / D) + 1e-6f);
    if (which == 2) {
#pragma unroll
      for (int i = 0; i < 8; ++i) {
        int cc = i * 256 + lane * 4;
        float4 o = make_float4(v[i].x * rstd * gs[i].x, v[i].y * rstd * gs[i].y, v[i].z * rstd * gs[i].z, v[i].w * rstd * gs[i].w);
        *reinterpret_cast<float4*>(p.out + (size_t)row * D + cc) = o;
      }
    } else {
#pragma unroll
      for (int i = 0; i < 8; ++i) {
        int cc = i * 256 + lane * 4;
        ushort4 o;
        o.x = f2bf(v[i].x * rstd * gs[i].x + hh[i].x);
        o.y = f2bf(v[i].y * rstd * gs[i].y + hh[i].y);
        o.z = f2bf(v[i].z * rstd * gs[i].z + hh[i].z);
        o.w = f2bf(v[i].w * rstd * gs[i].w + hh[i].w);
        *reinterpret_cast<ushort4*>(p.nbuf + (size_t)row * D + cc) = o;
      }
    }
  }
}

#define LAS __attribute__((address_space(3)))
typedef unsigned u32x4 __attribute__((ext_vector_type(4)));
constexpr int BM = 256, BK = 64, HALF = 128, HTB = HALF * BK * 2, NXCD = 8, WGM = 8;
__device__ __forceinline__ int lds_byte(int r, int c) {
  const int st = (r >> 4) * 2 + (c >> 5), rr = r & 15, cc = c & 31, ob = rr * 64 + cc * 2;
  return st * 1024 + (ob ^ (((ob >> 9) & 1) << 5));
}
__device__ __forceinline__ void stage_rc(int b, int& R, int& C) {
  const int st = b / 1024, sb = b % 1024, swz = sb ^ (((sb >> 9) & 1) << 5);
  R = (st >> 1) * 16 + swz / 64; C = (st & 1) * 32 + (swz % 64) / 2;
}
struct Unit { int pm, pn; };
struct StaticOrder {
  int nM, nN, nwg, G, c;
  __device__ void init(int M, int N, int G_, int c_) { nM = M / BM; nN = N / BM; nwg = nM * nN; G = G_; c = c_; }
  __device__ bool next(int i, Unit& u) const {
    const long L = (long)i * G + c; if (L >= nwg) return false;
    int wgid = (int)L;
    { const int q = nwg / NXCD, r = nwg % NXCD, xcd = wgid % NXCD, off = wgid / NXCD; wgid = (xcd < r ? xcd * (q + 1) : r * (q + 1) + (xcd - r) * q) + off; }
    const int nig = WGM * nN, gid = wgid / nig, fm = gid * WGM, gsz = (nM - fm) < WGM ? (nM - fm) : WGM;
    u.pm = fm + ((wgid % nig) % gsz); u.pn = (wgid % nig) / gsz; return true;
  }
};
__device__ __forceinline__ unsigned pk_bf16(float lo, float hi) { return (unsigned)f2bf(lo) | ((unsigned)f2bf(hi) << 16); }

struct EpiProj {
  u16* O;
  __device__ __forceinline__ void operator()(const f32x4 (&acc)[2][2][4][2], const Unit& u, int wr, int wc, int fr, int fq) const {
    const int row0 = u.pm * BM + wr * 64 + fr, col0 = u.pn * BM + wc * 32 + 4 * fq;
#pragma unroll
    for (int ai = 0; ai < 2; ++ai)
#pragma unroll
      for (int m = 0; m < 4; ++m) {
        u16* rowp = O + (size_t)(row0 + ai * HALF + m * 16) * PROJP + col0;
#pragma unroll
        for (int bj = 0; bj < 2; ++bj)
#pragma unroll
          for (int n = 0; n < 2; ++n) {
            f32x4 v = acc[ai][bj][m][n];
            uint2 w; w.x = pk_bf16(v[0], v[1]); w.y = pk_bf16(v[2], v[3]);
            *reinterpret_cast<uint2*>(rowp + bj * HALF + n * 16) = w;
          }
      }
  }
};
struct EpiGU {
  u16* O;
  __device__ __forceinline__ void operator()(const f32x4 (&acc)[2][2][4][2], const Unit& u, int wr, int wc, int fr, int fq) const {
    const int row0 = u.pm * BM + wr * 64 + fr, col0 = u.pn * HALF + wc * 32 + 4 * fq;
#pragma unroll
    for (int ai = 0; ai < 2; ++ai)
#pragma unroll
      for (int m = 0; m < 4; ++m) {
        u16* rowp = O + (size_t)(row0 + ai * HALF + m * 16) * FFN + col0;
#pragma unroll
        for (int n = 0; n < 2; ++n) {
          f32x4 g = acc[ai][0][m][n], up = acc[ai][1][m][n];
          uint2 w;
          w.x = pk_bf16(siluf_(g[0]) * up[0], siluf_(g[1]) * up[1]);
          w.y = pk_bf16(siluf_(g[2]) * up[2], siluf_(g[3]) * up[3]);
          *reinterpret_cast<uint2*>(rowp + n * 16) = w;
        }
      }
  }
};
struct EpiRes {
  const float* xin; const float* cin;
  float* out; float* hc; const float* gate;
  __device__ __forceinline__ void operator()(const f32x4 (&acc)[2][2][4][2], const Unit& u, int wr, int wc, int fr, int fq) const {
    const int row0 = u.pm * BM + wr * 64 + fr, col0 = u.pn * BM + wc * 32 + 4 * fq;
#pragma unroll
    for (int ai = 0; ai < 2; ++ai)
#pragma unroll
      for (int m = 0; m < 4; ++m) {
        const int row = row0 + ai * HALF + m * 16;
        const float* gp = gate + (size_t)condof(row) * 6 * D + col0;
        const float* hold; float* hnew;
        if (row < NX) { hnew = out + (size_t)row * D + col0; hold = xin ? xin + (size_t)row * D + col0 : hnew; }
        else { hnew = hc + (size_t)(row - NX) * D + col0; hold = cin ? cin + (size_t)(row - NX) * D + col0 : hnew; }
#pragma unroll
        for (int bj = 0; bj < 2; ++bj)
#pragma unroll
          for (int n = 0; n < 2; ++n) {
            f32x4 h = *reinterpret_cast<const f32x4*>(hold + bj * HALF + n * 16);
            f32x4 g = *reinterpret_cast<const f32x4*>(gp + bj * HALF + n * 16);
            *reinterpret_cast<f32x4*>(hnew + bj * HALF + n * 16) = h + g * acc[ai][bj][m][n];
          }
      }
  }
};

template <class Epi>
__device__ __forceinline__ void gemm_phase(LAS unsigned char* lds, const u16* gA, const u16* gBt, int M, int N, int K, const Epi& E) {
  const int tid = TIDX(), wid = __builtin_amdgcn_readfirstlane(tid >> 6), lane = tid & 63, wr = wid >> 2, wc = wid & 3, fr = lane & 15, fq = lane >> 4;
  const int nt = K / BK;
  StaticOrder S; S.init(M, N, gridDim.x, blockIdx.x);
  unsigned voffA[2], voffB[2];
#pragma unroll
  for (int i = 0; i < 2; ++i) { int R, C; stage_rc(tid * 16 + i * 8192, R, C); voffA[i] = (unsigned)(R * K + C) * 2u; voffB[i] = voffA[i]; }
  const size_t kstep = (size_t)(BK * 2);
  const size_t hstep = (size_t)HALF * K * 2;
  const size_t tstep = 2 * hstep;
  const unsigned ldsw = (unsigned)wid * 1024u;
  const int aoff = lds_byte(wr * 64 + fr, fq * 8), boff = lds_byte(wc * 32 + fr, fq * 8);
#define G_SA(b, h) (((b) * 2 + (h)) * HTB)
#define G_SB(b, h) ((4 + (b) * 2 + (h)) * HTB)
#define G_STAGE(bufoff, gbase, voff) do { _Pragma("unroll") for (int _i = 0; _i < 2; ++_i) \
    __builtin_amdgcn_global_load_lds((const unsigned*)((const char*)(gbase) + (voff)[_i]), (LAS unsigned*)(lds + (bufoff) + ldsw + _i * 8192), 16, 0, 0); } while (0)
#define G_LDA(dst, b, h) do { _Pragma("unroll") for (int m = 0; m < 4; ++m) _Pragma("unroll") for (int k = 0; k < 2; ++k) dst[m][k] = *(const LAS bf16x8*)(lds + G_SA(b, h) + aoff + m * 2048 + k * 1024); } while (0)
#define G_LDB(dst, b, h) do { _Pragma("unroll") for (int n = 0; n < 2; ++n) _Pragma("unroll") for (int k = 0; k < 2; ++k) dst[n][k] = *(const LAS bf16x8*)(lds + G_SB(b, h) + boff + n * 2048 + k * 1024); } while (0)
#define G_MMA(ai, bj, At, Bt) do { __builtin_amdgcn_s_setprio(1); _Pragma("unroll") for (int m = 0; m < 4; ++m) _Pragma("unroll") for (int n = 0; n < 2; ++n) _Pragma("unroll") for (int k = 0; k < 2; ++k) \
    acc[ai][bj][m][n] = __builtin_amdgcn_mfma_f32_16x16x32_bf16(Bt[n][k], At[m][k], acc[ai][bj][m][n], 0, 0, 0); __builtin_amdgcn_s_setprio(0); } while (0)
#define G_WAIT_V(n) asm volatile("s_waitcnt vmcnt(" #n ")" ::: "memory")
#define G_WAIT_L(n) asm volatile("s_waitcnt lgkmcnt(" #n ")" ::: "memory")
#define G_BAR __builtin_amdgcn_s_barrier()
#define G_SCHED __builtin_amdgcn_sched_barrier(0)
  Unit cur, nxt; int ui = 0;
  if (!S.next(0, cur)) return;
  f32x4 acc[2][2][4][2];
#pragma unroll
  for (int a = 0; a < 2; ++a)
#pragma unroll
    for (int b = 0; b < 2; ++b)
#pragma unroll
      for (int m = 0; m < 4; ++m)
#pragma unroll
        for (int n = 0; n < 2; ++n) acc[a][b][m][n] = (f32x4){0.f, 0.f, 0.f, 0.f};
  bf16x8 At[4][2], B0[2][2], B1[2][2];
  const char* cA = (const char*)gA + (size_t)cur.pm * tstep; const char* cB = (const char*)gBt + (size_t)cur.pn * tstep;
  G_STAGE(G_SB(0, 0), cB, voffB); G_STAGE(G_SA(0, 0), cA, voffA); G_STAGE(G_SB(0, 1), cB + hstep, voffB); G_STAGE(G_SA(0, 1), cA + hstep, voffA);
  if (wr == 1) G_BAR;
  G_WAIT_V(4); G_BAR;
  G_STAGE(G_SB(1, 0), cB + kstep, voffB); G_STAGE(G_SA(1, 0), cA + kstep, voffA); G_STAGE(G_SB(1, 1), cB + hstep + kstep, voffB);
  G_WAIT_V(6); G_BAR;
  for (;;) {
    const bool has_next = S.next(ui + 1, nxt);
    const char* nA = has_next ? (const char*)gA + (size_t)nxt.pm * tstep : cA; const char* nB = has_next ? (const char*)gBt + (size_t)nxt.pn * tstep : cB;
    for (int t = 0; t < nt; t += 2) {
      const bool last = (t == nt - 2);
      const char* a1 = cA + (size_t)(t + 1) * kstep;
      const char* a2 = last ? nA : cA + (size_t)(t + 2) * kstep; const char* b2 = last ? nB : cB + (size_t)(t + 2) * kstep;
      const char* a3 = a2 + kstep; const char* b3 = b2 + kstep;
      G_LDB(B0, 0, 0); G_SCHED; G_LDA(At, 0, 0); G_STAGE(G_SA(1, 1), a1 + hstep, voffA);
      G_WAIT_L(8); G_BAR; G_WAIT_L(0); G_MMA(0, 0, At, B0); G_BAR; G_SCHED;
      G_LDB(B1, 0, 1); G_STAGE(G_SB(0, 0), b2, voffB);
      G_BAR; G_WAIT_L(0); G_MMA(0, 1, At, B1); G_BAR;
      G_LDA(At, 0, 1); G_STAGE(G_SA(0, 0), a2, voffA);
      G_BAR; G_WAIT_L(0); G_MMA(1, 0, At, B0); G_BAR; G_SCHED;
      G_STAGE(G_SB(0, 1), b2 + hstep, voffB);
      G_WAIT_V(6); G_BAR; G_MMA(1, 1, At, B1); G_BAR;
      G_LDB(B0, 1, 0); G_SCHED; G_LDA(At, 1, 0); G_STAGE(G_SA(0, 1), a2 + hstep, voffA);
      G_WAIT_L(8); G_BAR; G_WAIT_L(0); G_MMA(0, 0, At, B0); G_BAR; G_SCHED;
      G_LDB(B1, 1, 1); G_STAGE(G_SB(1, 0), b3, voffB);
      G_BAR; G_WAIT_L(0); G_MMA(0, 1, At, B1); G_BAR;
      G_LDA(At, 1, 1); G_STAGE(G_SA(1, 0), a3, voffA);
      G_BAR; G_WAIT_L(0); G_MMA(1, 0, At, B0); G_BAR; G_SCHED;
      G_STAGE(G_SB(1, 1), b3 + hstep, voffB);
      G_WAIT_V(6); G_BAR; G_MMA(1, 1, At, B1); G_BAR;
    }
    E(acc, cur, wr, wc, fr, fq);
    if (!has_next) break;
#pragma unroll
    for (int a = 0; a < 2; ++a)
#pragma unroll
      for (int b = 0; b < 2; ++b)
#pragma unroll
        for (int m = 0; m < 4; ++m)
#pragma unroll
          for (int n = 0; n < 2; ++n) acc[a][b][m][n] = (f32x4){0.f, 0.f, 0.f, 0.f};
    cur = nxt; cA = nA; cB = nB; ++ui;
  }
  G_WAIT_V(0);
  if (wr == 0) G_BAR;
  G_BAR;
}

typedef float f32x2 __attribute__((ext_vector_type(2)));
constexpr int NCHK = CTX / TC + SEQ / TC;
__device__ __forceinline__ u16* osc_ptr(const P& p, int mixer, int dir) { return reinterpret_cast<u16*>(p.osc) + ((size_t)(mixer * 2 + dir)) * NT * 512; }
__device__ __forceinline__ float wave_sum_b(float v) {
  v = red16(v);
  v += __int_as_float(__builtin_amdgcn_update_dpp(0, __float_as_int(v), 0x142, 0xa, 0xf, false));
  v += __int_as_float(__builtin_amdgcn_update_dpp(0, __float_as_int(v), 0x143, 0xc, 0xf, false));
  return rdlane(v, 63);
}
__device__ __forceinline__ void chunk_pos(int g, int& seq, int& T, int& c0) {
  seq = g >= CTX / TC; T = seq ? SEQ : CTX; c0 = (seq ? g - CTX / TC : g) * TC;
}
#define L128(ptr, off) (*(const LAS f32x4*)((ptr) + (off)))
#define L64(ptr, off) (*(const LAS f32x2*)((ptr) + (off)))
#define L32(ptr, off) (*(const LAS float*)((ptr) + (off)))

constexpr int RW_VS = 360, RW_VB = RW_VS * 4;
constexpr int RW_OFF_Y = 2 * TC * RW_VB, RW_OFF_TW = RW_OFF_Y + 2 * TC * 32 * 4, RW_OFF_LW = RW_OFF_TW + 32 * 68 * 4, RW_OFF_LA = RW_OFF_LW + 32 * 68 * 4;
static_assert(RW_OFF_LA + 32 * 68 * 4 <= SHM_BYTES, "rwkv lds");
struct RwRaw { unsigned r[5], k[5], v[5]; float dec[4], av[4]; };
struct RwVec { f32x4 e0, e1, w, a, p; float vv; f32x2 cc; };
__device__ __forceinline__ void rw_load(const P& p, int b, int ch, int lane, int dir, int g, int wv, RwRaw& R) {
  int seq, T, c0; chunk_pos(g, seq, T, c0);
#pragma unroll
  for (int j = 0; j < 5; ++j) {
    int s = c0 + wv * 4 + j - 1;
    s = s < 0 ? 0 : s;
    int t = dir ? T - 1 - s : s;
    const u16* pr = p.projb + (unsigned)(tokrow(seq, b, t) * PROJP);
    R.r[j] = pr[O_RKV + ch]; R.k[j] = pr[O_RKV + 512 + ch]; R.v[j] = pr[O_RKV + 1024 + ch];
    if (j >= 1) {
      const unsigned o = (unsigned)(((size_t)dir * NT + tokrow(seq, b, t)) * 512 + ch);
      R.dec[j - 1] = p.rwd[o]; R.av[j - 1] = p.rwa[o];
    }
  }
}

__device__ void scan_rwkv(const P& p, int l, int b, int h, int dir, int rh, LAS char* lds) {
  const int tid = TIDX(), lane = tid & 63, wv = tid >> 6;
  const int ch = h * 64 + lane;
  const float* mu = p.rw_mu_rkv + ((size_t)l * 2 + dir) * 1536;
  const float mu_r = mu[ch], mu_k = mu[512 + ch], mu_v = mu[1024 + ch];
  const float kkw = p.rw_kk[(size_t)l * 512 + ch], kaw = p.rw_ka[(size_t)l * 512 + ch], rkw = p.rw_rk[(size_t)l * 512 + ch];
  u16* oy = osc_ptr(p, 2, dir);
  float* sb_out = p.sbon + (size_t)dir * NT * 8;
  f32x2 S2[2];
  S2[0] = (f32x2){0.f, 0.f}; S2[1] = (f32x2){0.f, 0.f};
  const int row = tid >> 4, kq = tid & 15;
  RwRaw R;

#define RW_PREP_C(G) do { \
    int seq_, T_, c0_; chunk_pos((G), seq_, T_, c0_); \
    LAS float* vbuf_ = (LAS float*)(lds + ((G) & 1) * TC * RW_VB); \
    _Pragma("unroll") for (int i = 0; i < 4; ++i) { \
      int si = wv * 4 + i, s = c0_ + si; \
      int t = dir ? T_ - 1 - s : s; \
      int rowg = tokrow(seq_, b, t); \
      const bool nop_ = (i == 0) && (wv == 0) && ((G) == 0 || (G) == CTX / TC); \
      float rc_ = bf2f((u16)R.r[i + 1]), kc_ = bf2f((u16)R.k[i + 1]), vc_ = bf2f((u16)R.v[i + 1]); \
      float rp_v = nop_ ? 0.f : bf2f((u16)R.r[i]), kp_v = nop_ ? 0.f : bf2f((u16)R.k[i]), vp_v = nop_ ? 0.f : bf2f((u16)R.v[i]); \
      float r = rc_ + (rp_v - rc_) * mu_r, k = kc_ + (kp_v - kc_) * mu_k, v = vc_ + (vp_v - vc_) * mu_v; \
      float decay = R.dec[i], a = R.av[i];     \
      float ku = k * kkw;                                     \
      float kp = k * (1.f + (a - 1.f) * kaw); \
      float ssq = wave_sum_b(ku * ku), s1 = wave_sum_b(ku * a * r), c2 = wave_sum_b(kp * r), sb = wave_sum_b(r * kp * rkw); \
      float rsq = rsqrtf(ssq + 1e-6f); \
      float kk = ku * rsq; \
      float kka = kk * a; \
      float c1 = rsq * s1; \
      if (lane == 0 && rh == 0) sb_out[(unsigned)(rowg * 8 + h)] = sb; \
      LAS float* vb = vbuf_ + si * RW_VS; \
      *(LAS f32x2*)(vb + 2 * lane + (lane >> 5) * 4) = (f32x2){kk, decay * r}; \
      vb[132 + lane] = decay; vb[196 + lane] = kka; vb[260 + lane] = kp; \
      if ((lane >> 5) == rh) vb[324 + (lane & 31)] = v; \
      if (lane == 0) *(LAS f32x2*)(vb + 356) = (f32x2){c1, c2}; \
    } } while (0)
#define RW_LDV(V, j_) do { \
    V.e0 = L128(bp, (j_) * RW_VB); V.e1 = L128(bp, (j_) * RW_VB + 16); V.w = L128(bq, (j_) * RW_VB + 528); V.a = L128(bq, (j_) * RW_VB + 784); \
    V.p = L128(bq, (j_) * RW_VB + 1040); V.vv = L32(bv, (j_) * RW_VB + 1296); V.cc = L64(bc, (j_) * RW_VB + 1424); } while (0)
#define RW_PIN(V) asm volatile("" : "+v"(V.e0), "+v"(V.e1), "+v"(V.w), "+v"(V.a), "+v"(V.p), "+v"(V.vv), "+v"(V.cc), "+v"(S2[0]), "+v"(S2[1]))
#define RW_STEP(V, j_) do { \
    f32x2 d = V.e0.xy * S2[0].x; d += V.e0.zw * S2[0].y; d += V.e1.xy * S2[1].x; d += V.e1.zw * S2[1].y; \
    f32x2 t0_ = S2[0] * V.w.xy + V.p.xy * V.vv, t1_ = S2[1] * V.w.zw + V.p.zw * V.vv;     \
    float sa = red16(d.x), yd = red16(d.y); \
    S2[0] = t0_ - V.a.xy * sa; S2[1] = t1_ - V.a.zw * sa; \
    float y_ = yd - sa * V.cc.x + V.vv * V.cc.y; ykeep = (kq == (j_)) ? y_ : ykeep; } while (0)
#define RW_2(jA, jB) RW_LDV(B, jA + 1); __builtin_amdgcn_sched_barrier(0); RW_STEP(A, jA); RW_PIN(B); \
                     RW_LDV(A, jB + 1); __builtin_amdgcn_sched_barrier(0); RW_STEP(B, jB); RW_PIN(A);

  rw_load(p, b, ch, lane, dir, 0, wv, R);
  RW_PREP_C(0);
  rw_load(p, b, ch, lane, dir, 1, wv, R);
  LBAR();
  for (int g = 0; g < NCHK; ++g) {
    LAS char* vbuf = lds + (g & 1) * TC * RW_VB;
    LAS float* ybuf = (LAS float*)(lds + RW_OFF_Y + (g & 1) * TC * 32 * 4);
    {
      RwVec A, B;
      LAS char* bp = vbuf + kq * 32 + (kq >> 3) * 16; LAS char* bq = vbuf + kq * 16; LAS char* bv = vbuf + row * 4; LAS char* bc = vbuf;
      RW_LDV(A, 0); RW_PIN(A);
#pragma unroll 1
      for (int s16 = 0; s16 < TC; s16 += 16) {
        float ykeep = 0.f;
        RW_2(0, 1) RW_2(2, 3) RW_2(4, 5) RW_2(6, 7) RW_2(8, 9) RW_2(10, 11) RW_2(12, 13) RW_2(14, 15)
        ybuf[(s16 + kq) * 32 + row] = ykeep;
        bp += 16 * RW_VB; bq += 16 * RW_VB; bv += 16 * RW_VB; bc += 16 * RW_VB;
      }
    }
    if (g + 1 < NCHK) RW_PREP_C(g + 1);
    if (g + 2 < NCHK) rw_load(p, b, ch, lane, dir, g + 2, wv, R);
    LBAR();
    {
      int seq, T, c0; chunk_pos(g, seq, T, c0);
#pragma unroll
      for (int q = 0; q < TC * 32 / NTHR; ++q) {
        int e = tid + q * NTHR;
        int si = e >> 5, rr = e & 31, s = c0 + si, t = dir ? T - 1 - s : s;
        oy[(unsigned)(tokrow(seq, b, t) * 512) + h * 64 + rh * 32 + rr] = f2bf(ybuf[e]);
      }
    }
  }
#undef RW_PREP_C
#undef RW_LDV
#undef RW_PIN
#undef RW_STEP
#undef RW_2
}

struct GlRaw { unsigned q[8], k[8], v[8]; float f[8], kq[8]; };
struct GlVec { f32x4 f0, f1, k0, k1, q0, q1; float vv, kq; };
template <int TPW, int NCOL>
__device__ __forceinline__ void gl_load(const P& p, int b, int ch, int vch, int lane, int dir, int g, int wv, GlRaw& R) {
  int seq, T, c0; chunk_pos(g, seq, T, c0);
#pragma unroll
  for (int i = 0; i < TPW; ++i) {
    int s = c0 + wv * TPW + i, t = dir ? T - 1 - s : s;
    const u16* pr = p.projb + (unsigned)(tokrow(seq, b, t) * PROJP);
    R.q[i] = pr[O_GQ + ch]; R.k[i] = pr[O_GK + ch]; R.v[i] = pr[O_GV + vch + (lane & (NCOL - 1))];
    R.f[i] = p.glf[(unsigned)(((size_t)dir * NT + tokrow(seq, b, t)) * 256 + ch)];
    R.kq[i] = p.kqa[(unsigned)(tokrow(seq, b, t) * 8 + 4 + (ch >> 6))];
  }
}
template <int NW>
__device__ void scan_gla(const P& p, int l, int b, int h, int dir, int part, LAS char* lds) {
  constexpr int NCOL = NW * 8, TPW = TC / NW, NTH = NW * 64, GL_VS = 196 + NCOL, GL_VB = GL_VS * 4, GL_OFF_V = 192 * 4, GL_OFF_S = (192 + NCOL) * 4, GL_OFF_Y = 2 * TC * GL_VB;
  const int tid = TIDX(), lane = tid & 63, wv = (tid >> 6) & (NW - 1), tl = tid & (NTH - 1);
  const int ch = h * 64 + lane;
  u16* oo = osc_ptr(p, 0, dir);
  f32x2 S2[4];
#pragma unroll
  for (int i = 0; i < 4; ++i) S2[i] = (f32x2){0.f, 0.f};
  const int col = tl >> 3, dq = tl & 7;
  const int vch = h * 128 + part * NCOL;
  GlRaw R;
#define GL_PREP(G) do { \
    LAS float* vbuf_ = (LAS float*)(lds + ((G) & 1) * TC * GL_VB); \
    _Pragma("unroll") for (int i = 0; i < TPW; ++i) { \
      int si = wv * TPW + i; \
      float q = bf2f((u16)R.q[i]) * 0.125f, k = bf2f((u16)R.k[i]), v = bf2f((u16)R.v[i]), f = R.f[i]; \
      float kq_ = R.kq[i]; \
      LAS float* vb = vbuf_ + si * GL_VS; \
      vb[lane] = f; vb[64 + lane] = k; vb[128 + lane] = f * q; if (lane < NCOL) vb[192 + lane] = v; \
      if (lane == 0) vb[192 + NCOL] = kq_; \
    } } while (0)
#define GL_LDV(V, j_) do { \
    V.f0 = L128(bq, (j_) * GL_VB); V.f1 = L128(bq, (j_) * GL_VB + 16); V.k0 = L128(bq, (j_) * GL_VB + 256); V.k1 = L128(bq, (j_) * GL_VB + 272); \
    V.q0 = L128(bq, (j_) * GL_VB + 512); V.q1 = L128(bq, (j_) * GL_VB + 528); V.vv = L32(bv, (j_) * GL_VB + GL_OFF_V); V.kq = L32(bc, (j_) * GL_VB + GL_OFF_S); } while (0)
#define GL_PIN(V) asm volatile("" : "+v"(V.f0), "+v"(V.f1), "+v"(V.k0), "+v"(V.k1), "+v"(V.q0), "+v"(V.q1), "+v"(V.vv), "+v"(V.kq), "+v"(S2[0]), "+v"(S2[1]), "+v"(S2[2]), "+v"(S2[3]))
#define GL_STEP(V, j_) do { \
    f32x2 o2 = S2[0] * V.q0.xy; o2 += S2[1] * V.q0.zw; o2 += S2[2] * V.q1.xy; o2 += S2[3] * V.q1.zw; \
    S2[0] = S2[0] * V.f0.xy + V.k0.xy * V.vv; S2[1] = S2[1] * V.f0.zw + V.k0.zw * V.vv; \
    S2[2] = S2[2] * V.f1.xy + V.k1.xy * V.vv; S2[3] = S2[3] * V.f1.zw + V.k1.zw * V.vv; \
    float o_ = red8(o2.x + o2.y) + V.vv * V.kq; ykeep = (dq == (j_)) ? o_ : ykeep; } while (0)
#define GL_2(jA, jB) GL_LDV(B, jA + 1); __builtin_amdgcn_sched_barrier(0); GL_STEP(A, jA); GL_PIN(B); \
                     GL_LDV(A, jB + 1); __builtin_amdgcn_sched_barrier(0); GL_STEP(B, jB); GL_PIN(A);
  gl_load<TPW, NCOL>(p, b, ch, vch, lane, dir, 0, wv, R);
  GL_PREP(0);
  gl_load<TPW, NCOL>(p, b, ch, vch, lane, dir, 1, wv, R);
  LBAR();
  for (int g = 0; g < NCHK; ++g) {
    LAS char* vbuf = lds + (g & 1) * TC * GL_VB;
    LAS float* obuf = (LAS float*)(lds + GL_OFF_Y + (g & 1) * TC * NCOL * 4);
    {
      GlVec A, B;
      LAS char* bq = vbuf + dq * 32; LAS char* bv = vbuf + col * 4; LAS char* bc = vbuf;
      GL_LDV(A, 0); GL_PIN(A);
#pragma unroll 1
      for (int s8 = 0; s8 < TC; s8 += 8) {
        float ykeep = 0.f;
        GL_2(0, 1) GL_2(2, 3) GL_2(4, 5) GL_2(6, 7)
        obuf[(s8 + dq) * NCOL + col] = ykeep;
        bq += 8 * GL_VB; bv += 8 * GL_VB; bc += 8 * GL_VB;
      }
    }
    if (g + 1 < NCHK) GL_PREP(g + 1);
    if (g + 2 < NCHK) gl_load<TPW, NCOL>(p, b, ch, vch, lane, dir, g + 2, wv, R);
    LBAR();
    {
      int seq, T, c0; chunk_pos(g, seq, T, c0);
#pragma unroll
      for (int q = 0; q < TC * NCOL / NTH; ++q) {
        int e = tl + q * NTH;
        int si = e / NCOL, cc = e % NCOL, s = c0 + si, t = dir ? T - 1 - s : s;
        oo[(unsigned)(tokrow(seq, b, t) * 512) + vch + cc] = f2bf(obuf[e]);
      }
    }
  }
#undef GL_PREP
#undef GL_LDV
#undef GL_PIN
#undef GL_STEP
#undef GL_2
}

struct GdRaw { unsigned q0[8], q1[8], k0[8], k1[8], v[8]; float2 ab[8]; float kq[8]; };
struct GdVec { f32x4 k0, k1, k2, k3, q0, q1, q2, q3; float vv; f32x4 abk; };
template <int TPW>
__device__ __forceinline__ void gd_load(const P& p, int b, int h, int qc0, int vc, int dir, int g, int wv, GdRaw& R) {
  int seq, T, c0; chunk_pos(g, seq, T, c0);
#pragma unroll
  for (int i = 0; i < TPW; ++i) {
    int s = c0 + wv * TPW + i;
    int t = dir ? T - 1 - s : s;
    int rowg = tokrow(seq, b, t);
    const u16* pq = p.nbuf + (unsigned)(rowg * D);
    R.q0[i] = pq[qc0]; R.q1[i] = pq[qc0 + 64]; R.k0[i] = pq[512 + qc0]; R.k1[i] = pq[512 + qc0 + 64]; R.v[i] = pq[vc];
    R.ab[i] = *reinterpret_cast<const float2*>(p.gab + (((size_t)dir * NT + rowg) * 4 + h) * 2);
    R.kq[i] = p.kqa[(unsigned)(rowg * 8 + h)];
  }
}
template <int NW>
__device__ void scan_gdn(const P& p, int l, int b, int h, int dir, int part, LAS char* lds) {
  constexpr int NCOL = NW * 8, TPW = TC / NW, NTH = NW * 64, GD_VS = 276 + NCOL, GD_VB = GD_VS * 4, GD_OFF_V = 272 * 4, GD_OFF_S = (272 + NCOL) * 4, GD_OFF_Y = 2 * TC * GD_VB;
  const int tid = TIDX(), lane = tid & 63, wv = (tid >> 6) & (NW - 1), tl = tid & (NTH - 1);
  const int qc0 = h * 128 + lane;
  const int vcol = h * 128 + part * NCOL;
  const int vc = 1024 + vcol + (lane & (NCOL - 1));
  u16* oo = osc_ptr(p, 1, dir);
  f32x2 S2[8];
#pragma unroll
  for (int i = 0; i < 8; ++i) S2[i] = (f32x2){0.f, 0.f};
  const int col = tl >> 3, dq = tl & 7;
  float alpha = 1.f;
  GdRaw R;
#define GD_PREP(G) do { \
    LAS float* vbuf_ = (LAS float*)(lds + ((G) & 1) * TC * GD_VB); \
    _Pragma("unroll") for (int i = 0; i < TPW; ++i) { \
      int si = wv * TPW + i; \
      float q0 = bf2f((u16)R.q0[i]), q1 = bf2f((u16)R.q1[i]), k0 = bf2f((u16)R.k0[i]), k1 = bf2f((u16)R.k1[i]), v = bf2f((u16)R.v[i]); \
      float kqd = R.kq[i]; \
      float a = R.ab[i].x, beta = R.ab[i].y;     \
      LAS float* vb = vbuf_ + si * GD_VS; \
      vb[lane] = k0; vb[68 + lane] = k1; vb[136 + lane] = q0; vb[204 + lane] = q1; if (lane < NCOL) vb[272 + lane] = v; \
      { float sv_ = lane == 0 ? a : (lane == 1 ? beta : kqd); if (lane < 3) vb[272 + NCOL + lane] = sv_; } \
    } } while (0)
#define GD_LDV(V, j_) do { \
    V.k0 = L128(bk, (j_) * GD_VB); V.k1 = L128(bk, (j_) * GD_VB + 16); V.k2 = L128(bk, (j_) * GD_VB + 32); V.k3 = L128(bk, (j_) * GD_VB + 48); \
    V.q0 = L128(bk, (j_) * GD_VB + 544); V.q1 = L128(bk, (j_) * GD_VB + 560); V.q2 = L128(bk, (j_) * GD_VB + 576); V.q3 = L128(bk, (j_) * GD_VB + 592); \
    V.vv = L32(bv, (j_) * GD_VB + GD_OFF_V); V.abk = L128(bc, (j_) * GD_VB + GD_OFF_S); } while (0)
#define GD_PIN(V) asm volatile("" : "+v"(V.k0), "+v"(V.k1), "+v"(V.k2), "+v"(V.k3), "+v"(V.q0), "+v"(V.q1), "+v"(V.q2), "+v"(V.q3), "+v"(V.vv), "+v"(V.abk), \
    "+v"(S2[0]), "+v"(S2[1]), "+v"(S2[2]), "+v"(S2[3]), "+v"(S2[4]), "+v"(S2[5]), "+v"(S2[6]), "+v"(S2[7]))
#define GD_STEP(V, j_) do { \
    f32x2 dk = S2[0] * V.k0.xy; dk += S2[1] * V.k0.zw; dk += S2[2] * V.k1.xy; dk += S2[3] * V.k1.zw; \
    dk += S2[4] * V.k2.xy; dk += S2[5] * V.k2.zw; dk += S2[6] * V.k3.xy; dk += S2[7] * V.k3.zw; \
    f32x2 dq_ = S2[0] * V.q0.xy; dq_ += S2[1] * V.q0.zw; dq_ += S2[2] * V.q1.xy; dq_ += S2[3] * V.q1.zw; \
    dq_ += S2[4] * V.q2.xy; dq_ += S2[5] * V.q2.zw; dq_ += S2[6] * V.q3.xy; dq_ += S2[7] * V.q3.zw; \
    float ks = red8(dk.x + dk.y), qs = red8(dq_.x + dq_.y);     \
    alpha *= V.abk.x;                                              \
    float cf = V.abk.y * (V.vv - alpha * ks); \
    float coef = cf * __builtin_amdgcn_rcpf(alpha); \
    S2[0] += V.k0.xy * coef; S2[1] += V.k0.zw * coef; S2[2] += V.k1.xy * coef; S2[3] += V.k1.zw * coef; \
    S2[4] += V.k2.xy * coef; S2[5] += V.k2.zw * coef; S2[6] += V.k3.xy * coef; S2[7] += V.k3.zw * coef; \
    float o_ = alpha * qs + cf * V.abk.z; ykeep = (dq == (j_)) ? o_ : ykeep; \
    if (((j_) & 3) == 3) { \
      S2[0] *= alpha; S2[1] *= alpha; S2[2] *= alpha; S2[3] *= alpha; S2[4] *= alpha; S2[5] *= alpha; S2[6] *= alpha; S2[7] *= alpha; alpha = 1.f; } \
    } while (0)
#define GD_2(jA, jB) GD_LDV(B, jA + 1); __builtin_amdgcn_sched_barrier(0); GD_STEP(A, jA); GD_PIN(B); \
                     GD_LDV(A, jB + 1); __builtin_amdgcn_sched_barrier(0); GD_STEP(B, jB); GD_PIN(A);
  gd_load<TPW>(p, b, h, qc0, vc, dir, 0, wv, R);
  GD_PREP(0);
  gd_load<TPW>(p, b, h, qc0, vc, dir, 1, wv, R);
  LBAR();
  for (int g = 0; g < NCHK; ++g) {
    LAS char* vbuf = lds + (g & 1) * TC * GD_VB;
    LAS float* obuf = (LAS float*)(lds + GD_OFF_Y + (g & 1) * TC * NCOL * 4);
    {
      GdVec A, B;
      LAS char* bk = vbuf + dq * 64 + (dq >> 2) * 16; LAS char* bv = vbuf + col * 4; LAS char* bc = vbuf;
      GD_LDV(A, 0); GD_PIN(A);
#pragma unroll 1
      for (int s8 = 0; s8 < TC; s8 += 8) {
        float ykeep = 0.f;
        GD_2(0, 1) GD_2(2, 3) GD_2(4, 5) GD_2(6, 7)
        obuf[(s8 + dq) * NCOL + col] = ykeep;
        bk += 8 * GD_VB; bv += 8 * GD_VB; bc += 8 * GD_VB;
      }
    }
    if (g + 1 < NCHK) GD_PREP(g + 1);
    if (g + 2 < NCHK) gd_load<TPW>(p, b, h, qc0, vc, dir, g + 2, wv, R);
    LBAR();
    {
      int seq, T, c0; chunk_pos(g, seq, T, c0);
#pragma unroll
      for (int q = 0; q < TC * NCOL / NTH; ++q) {
        int e = tl + q * NTH;
        int si = e / NCOL, cc = e % NCOL, s = c0 + si, t = dir ? T - 1 - s : s;
        oo[(unsigned)(tokrow(seq, b, t) * 512) + vcol + cc] = f2bf(obuf[e]);
      }
    }
  }
#undef GD_PREP
#undef GD_LDV
#undef GD_PIN
#undef GD_STEP
#undef GD_2
}

constexpr int MIX_GDN_LDS = 2 * TC * (276 + 32) * 4 + 2 * TC * 32 * 4;
constexpr int MIX_GLA_LDS = 2 * TC * (196 + 32) * 4 + 2 * TC * 32 * 4;
constexpr int LDS_TOTAL = MIX_GDN_LDS + MIX_GLA_LDS + 16;
__device__ void phase_scan(const P& p, int l, LAS char* lds) {
  for (int w = blockIdx.x; w < 256; w += gridDim.x) {
    const int x = w & 7, j = w >> 3;
    if ((x & 1) == 0) {
      int u = (x >> 1) * 32 + j;
      scan_rwkv(p, l, u >> 5, (u >> 2) & 7, (u >> 1) & 1, u & 1, lds);
    } else {
      const int m = (x >> 1) * 32 + j;
      const int wid = __builtin_amdgcn_readfirstlane(TIDX() >> 6);
      if (wid < 4) scan_gdn<4>(p, l, m >> 5, (m >> 3) & 3, (m >> 2) & 1, m & 3, lds);
      else scan_gla<4>(p, l, m >> 5, (m >> 3) & 3, (m >> 2) & 1, m & 3, lds + MIX_GDN_LDS);
    }
    __syncthreads();
  }
}

__device__ void phase_gdnprep(const P& p, int l, float* lds) {
  const int tid = TIDX(), lane = tid & 63, wv = tid >> 6;
  const float* cw = p.gdn_conv + (size_t)l * 3 * 1536;
  const int nw = gridDim.x * 8;
  float* aup_s = lds;
  for (int e = tid; e < 2 * 16 * 256; e += NTHR) aup_s[e] = p.gla_a_up[(size_t)l * 2 * 16 * 256 + e];
  float4 abias[2];
  abias[0] = *reinterpret_cast<const float4*>(p.gla_a_b + ((size_t)l * 2 + 0) * 256 + lane * 4);
  abias[1] = *reinterpret_cast<const float4*>(p.gla_a_b + ((size_t)l * 2 + 1) * 256 + lane * 4);
  const float gA = __expf(p.gdn_a_log[(size_t)l * 8 + (lane & 7)]), gdt = p.gdn_dt_bias[(size_t)l * 8 + (lane & 7)];
  __syncthreads();
  {
    float* tw_s = lds + 2 * 16 * 256 + 3 * 1536;
    const int fr = lane & 15, fq = lane >> 4;
#pragma unroll 1
    for (int dir = 0; dir < 2; ++dir) {
      float bw[8][4], ba[8][4], w0v[4], a0v[4];
#pragma unroll
      for (int nt = 0; nt < 4; ++nt) {
        const int chn = wv * 64 + nt * 16 + fr;
        w0v[nt] = p.rw_w0[((size_t)l * 2 + dir) * 512 + chn]; a0v[nt] = p.rw_a0[((size_t)l * 2 + dir) * 512 + chn];
#pragma unroll
        for (int k4 = 0; k4 < 8; ++k4) {
          bw[k4][nt] = p.rw_w2[(((size_t)l * 2 + dir) * 32 + k4 * 4 + fq) * 512 + chn];
          ba[k4][nt] = p.rw_a2[(((size_t)l * 2 + dir) * 32 + k4 * 4 + fq) * 512 + chn];
        }
      }
      const float mu_wa = p.rw_mu_wa[((size_t)l * 2 + dir) * 64 + lane];
      float* dD = p.rwd + (size_t)dir * NT * 512;
      float* dA = p.rwa + (size_t)dir * NT * 512;
      unsigned nwc[2], nwp[2];
#define RWP_LOAD(tile_) do { const int R0_ = (tile_) * 16; const int sq_ = R0_ < NX ? 1 : 0, T_ = sq_ ? SEQ : CTX; \
        const int tq0_ = (sq_ ? R0_ : R0_ - NX) & (T_ - 1); \
        _Pragma("unroll") for (int q = 0; q < 2; ++q) { const int tk = wv + 8 * q, t = tq0_ + tk, tp = dir ? t + 1 : t - 1; \
          const bool hp = tp >= 0 && tp < T_; const u16* pr = p.projb + (size_t)(R0_ + tk) * PROJP + O_RWA + lane; \
          nwc[q] = pr[0]; nwp[q] = pr[hp ? (dir ? PROJP : -PROJP) : 0]; } } while (0)
      if ((int)blockIdx.x < NT / 16) RWP_LOAD(blockIdx.x);
#pragma unroll 1
      for (int tile = blockIdx.x; tile < NT / 16; tile += gridDim.x) {
        const int R0 = tile * 16;
        const int sq = R0 < NX ? 1 : 0, T = sq ? SEQ : CTX;
        const int tq0 = (sq ? R0 : R0 - NX) & (T - 1);
#pragma unroll
        for (int q = 0; q < 2; ++q) {
          const int tk = wv + 8 * q, t = tq0 + tk, tp = dir ? t + 1 : t - 1;
          const bool hp = tp >= 0 && tp < T;
          float wc = bf2f((u16)nwc[q]);
          float wp = hp ? bf2f((u16)nwp[q]) : 0.f;
          float xwa = wc + (wp - wc) * mu_wa;
          tw_s[tk * 68 + lane] = lane < 32 ? tanhf_(xwa) : xwa;
        }
        if (tile + (int)gridDim.x < NT / 16) RWP_LOAD(tile + gridDim.x);
        LBAR();
        float aw[8], aa[8];
#pragma unroll
        for (int k4 = 0; k4 < 8; ++k4) { aw[k4] = tw_s[fr * 68 + k4 * 4 + fq]; aa[k4] = tw_s[fr * 68 + 32 + k4 * 4 + fq]; }
#pragma unroll
        for (int nt = 0; nt < 4; ++nt) {
          f32x4 cw = (f32x4){0.f, 0.f, 0.f, 0.f}, ca = cw;
#pragma unroll
          for (int k4 = 0; k4 < 8; ++k4) {
            cw = __builtin_amdgcn_mfma_f32_16x16x4f32(aw[k4], bw[k4][nt], cw, 0, 0, 0);
            ca = __builtin_amdgcn_mfma_f32_16x16x4f32(aa[k4], ba[k4][nt], ca, 0, 0, 0);
          }
#pragma unroll
          for (int j = 0; j < 4; ++j) {
            const size_t o = (size_t)(R0 + fq * 4 + j) * 512 + wv * 64 + nt * 16 + fr;
            dD[o] = __expf(-0.6065306597126334f * sigmoidf_(w0v[nt] + cw[j]));
            dA[o] = sigmoidf_(a0v[nt] + ca[j]);
          }
        }
        LBAR();
      }
    }
  }
  for (int row = blockIdx.x * 8 + wv; row < NT; row += nw) {
    const int seq = row < NX ? 1 : 0;
    const int RL = seq ? 64 : 256;
    const int t = (seq ? row : row - NX) & (RL - 1);
    const float ml = t != 0 ? 1.f : 0.f, mr = t != RL - 1 ? 1.f : 0.f;
    const u16* pc = p.projb + (size_t)row * PROJP + O_DQKV;
    const u16* pl = pc - (t != 0 ? PROJP : 0);
    const u16* pn = pc + (t != RL - 1 ? PROJP : 0);
    float x[24];
    unsigned rc[24], rl[24], rr[24];
#pragma unroll
    for (int j = 0; j < 24; ++j) { const int c = j * 64 + lane; rc[j] = pc[c]; rl[j] = pl[c]; rr[j] = pn[c]; }
    unsigned glo_raw = p.projb[(size_t)row * PROJP + O_GLO + (lane & 15)], dab_raw = p.projb[(size_t)row * PROJP + O_DA + (lane & 15)];
    unsigned glq[4], glk[4];
#pragma unroll
    for (int j = 0; j < 4; ++j) { glq[j] = p.projb[(size_t)row * PROJP + O_GQ + j * 64 + lane]; glk[j] = p.projb[(size_t)row * PROJP + O_GK + j * 64 + lane]; }
    asm volatile("" : "+v"(glo_raw), "+v"(dab_raw), "+v"(glq[0]), "+v"(glq[1]), "+v"(glq[2]), "+v"(glq[3]), "+v"(glk[0]), "+v"(glk[1]), "+v"(glk[2]), "+v"(glk[3]));
#define PIN8(a, o) asm volatile("" : "+v"(a[o]), "+v"(a[o + 1]), "+v"(a[o + 2]), "+v"(a[o + 3]), "+v"(a[o + 4]), "+v"(a[o + 5]), "+v"(a[o + 6]), "+v"(a[o + 7]))
    PIN8(rc, 0); PIN8(rc, 8); PIN8(rc, 16); PIN8(rl, 0); PIN8(rl, 8); PIN8(rl, 16); PIN8(rr, 0); PIN8(rr, 8); PIN8(rr, 16);
#pragma unroll
    for (int g8 = 0; g8 < 3; ++g8) {
      float w0[8], w1[8], w2[8];
      const float* cwl = cw; asm volatile("" : "+s"(cwl));
#pragma unroll
      for (int j = 0; j < 8; ++j) { const int c = (g8 * 8 + j) * 64 + lane; w0[j] = cwl[c]; w1[j] = cwl[1536 + c]; w2[j] = cwl[3072 + c]; }
      PIN8(w0, 0); PIN8(w1, 0); PIN8(w2, 0);
#pragma unroll
      for (int j = 0; j < 8; ++j) {
        float xc = bf2f((u16)rc[g8 * 8 + j]), xl = bf2f((u16)rl[g8 * 8 + j]) * ml, xr = bf2f((u16)rr[g8 * 8 + j]) * mr;
        x[g8 * 8 + j] = siluf_(xl * w0[j] + xc * w1[j] + xr * w2[j]);
      }
    }
#undef PIN8
    {
      float glo = bf2f((u16)glo_raw);
      float dab = bf2f((u16)dab_raw);
#pragma unroll
      for (int dir = 0; dir < 2; ++dir) {
        float4 acc = abias[dir];
#pragma unroll
        for (int m = 0; m < 16; ++m) {
          float g = rdlane(glo, m);
          float4 w = *reinterpret_cast<const float4*>(aup_s + (dir * 16 + m) * 256 + lane * 4);
          acc.x += g * w.x; acc.y += g * w.y; acc.z += g * w.z; acc.w += g * w.w;
        }
        float4 f;
        f.x = __expf((fminf(acc.x, 0.f) - __logf(1.f + __expf(-fabsf(acc.x)))) * (1.f / 16.f));
        f.y = __expf((fminf(acc.y, 0.f) - __logf(1.f + __expf(-fabsf(acc.y)))) * (1.f / 16.f));
        f.z = __expf((fminf(acc.z, 0.f) - __logf(1.f + __expf(-fabsf(acc.z)))) * (1.f / 16.f));
        f.w = __expf((fminf(acc.w, 0.f) - __logf(1.f + __expf(-fabsf(acc.w)))) * (1.f / 16.f));
        *reinterpret_cast<float4*>(p.glf + ((size_t)dir * NT + row) * 256 + lane * 4) = f;
      }
      float db_v = __shfl(dab, (lane & 7) + 8);
      float a_v = fmaxf(__expf(-gA * softplusf_(dab + gdt)), 1e-9f);
      float b_v = sigmoidf_(db_v);
      if (lane < 8) *reinterpret_cast<float2*>(p.gab + (((size_t)(lane >> 2) * NT + row) * 4 + (lane & 3)) * 2) = make_float2(a_v, b_v);
    }
    u16* dst = p.nbuf + (size_t)row * D;
#pragma unroll
    for (int hh = 0; hh < 4; ++hh) {
      float qs = wave_sum_b(x[2 * hh] * x[2 * hh] + x[2 * hh + 1] * x[2 * hh + 1]);
      float ks = wave_sum_b(x[8 + 2 * hh] * x[8 + 2 * hh] + x[8 + 2 * hh + 1] * x[8 + 2 * hh + 1]);
      float qn = rsqrtf(qs + 1e-6f) * 0.08838834764831845f, kn = rsqrtf(ks + 1e-6f);
      u16 q0b = f2bf(x[2 * hh] * qn), q1b = f2bf(x[2 * hh + 1] * qn), k0b = f2bf(x[8 + 2 * hh] * kn), k1b = f2bf(x[8 + 2 * hh + 1] * kn);
      float kqd = wave_sum_b(bf2f(k0b) * bf2f(q0b) + bf2f(k1b) * bf2f(q1b));
      float kql = wave_sum_b(bf2f((u16)glq[hh]) * 0.125f * bf2f((u16)glk[hh]));
      if (lane == 0) { p.kqa[(size_t)row * 8 + hh] = kqd; p.kqa[(size_t)row * 8 + 4 + hh] = kql; }
      dst[(2 * hh) * 64 + lane] = q0b; dst[(2 * hh + 1) * 64 + lane] = q1b;
      dst[512 + (2 * hh) * 64 + lane] = k0b; dst[512 + (2 * hh + 1) * 64 + lane] = k1b;
      dst[1024 + (2 * hh) * 64 + lane] = f2bf(x[16 + 2 * hh]); dst[1024 + (2 * hh + 1) * 64 + lane] = f2bf(x[16 + 2 * hh + 1]);
    }
  }
}

__device__ void phase_combine(const P& p, int l, int ntok, float* lds) {
  float* sig = lds;
  const int tid = TIDX(), lane = tid & 63, wv = tid >> 6;
  const float* g2 = p.rw_g2 + (size_t)l * 96 * 512;
  float g2r[96];
#pragma unroll
  for (int m = 0; m < 96; ++m) g2r[m] = g2[m * 512 + tid];
  const float gnw = p.rw_gn_w[(size_t)l * 512 + tid], gnb = p.rw_gn_b[(size_t)l * 512 + tid];
  const float muvf = p.rw_mu_rkv[((size_t)l * 2 + 0) * 1536 + 1024 + tid];
  const float muvb = p.rw_mu_rkv[((size_t)l * 2 + 1) * 1536 + 1024 + tid];
  const float scw0 = p.sc_conv[(size_t)l * 1536 + tid], scw1 = p.sc_conv[(size_t)l * 1536 + 512 + tid],
              scw2 = p.sc_conv[(size_t)l * 1536 + 1024 + tid];
  const int mixer = wv >> 2, hh = wv & 3;
  const float* ng = (mixer == 0 ? p.gla_norm_g : p.gdn_norm_g) + (size_t)l * 128;
  const float ng0 = ng[lane], ng1 = ng[lane + 64];
  const u16* om0 = osc_ptr(p, mixer, 0);
  const u16* om1 = osc_ptr(p, mixer, 1);
  const u16* or0 = osc_ptr(p, 2, 0);
  const u16* or1 = osc_ptr(p, 2, 1);
  const int gch = (mixer == 0 ? O_GR : O_DZ) + hh * 128 + lane;
  for (int tile = blockIdx.x; tile < ntok / 16; tile += gridDim.x) {
    const int r0 = tile * 16;
    const int seq = r0 < NX ? 1 : 0;
    const int T = seq ? SEQ : CTX, RL = seq ? 64 : 256;
    const int tb = (seq ? r0 : r0 - NX) & (T - 1);
    __syncthreads();
    for (int e = tid; e < 16 * 96; e += NTHR) {
      int i = e / 96, m = e % 96;
      sig[e] = sigmoidf_(bf2f(p.projb[(size_t)(r0 + i) * PROJP + O_RG + m]));
    }
    __syncthreads();
#define PIN8(a) asm volatile("" : "+v"(a[0]), "+v"(a[1]), "+v"(a[2]), "+v"(a[3]))
#pragma unroll 1
    for (int i0 = 0; i0 < 16; i0 += 4) {
      float sf[4], sb[4];
      unsigned y0[4], y1[4], a0[4], a1[4], a2[4], a3[4], vc[4], vp[4], vn[4], g0r[4], g1r[4], cbr[4], ucc[6], uch[6];
#pragma unroll
      for (int i = 0; i < 4; ++i) {
        int row = r0 + i0 + i, t = tb + i0 + i;
        y0[i] = or0[(size_t)row * 512 + tid]; y1[i] = or1[(size_t)row * 512 + tid];
        const u16* pv = p.projb + (size_t)row * PROJP + O_RKV + 1024 + tid;
        vc[i] = pv[0]; vp[i] = pv[t > 0 ? -PROJP : 0]; vn[i] = pv[t < T - 1 ? PROJP : 0];
        sf[i] = p.sbon[(size_t)row * 8 + wv]; sb[i] = p.sbon[(size_t)NT * 8 + (size_t)row * 8 + wv];
        size_t ob = (size_t)row * 512 + hh * 128 + lane;
        a0[i] = om0[ob]; a1[i] = om1[ob]; a2[i] = om0[ob + 64]; a3[i] = om1[ob + 64];
        const u16* pg = p.projb + (size_t)row * PROJP + gch;
        g0r[i] = pg[0]; g1r[i] = pg[64];
        cbr[i] = p.projb[(size_t)row * PROJP + O_CB + tid];
      }
      {
        const u16* pc = p.projb + (size_t)(r0 + i0) * PROJP;
#pragma unroll
        for (int j = 0; j < 6; ++j) {
          int t = tb + i0 + j - 1;
          int off = (t < 0 ? 0 : (t > T - 1 ? T - 1 : t)) - (tb + i0);
          const u16* pr = pc + (long)off * PROJP;
          ucc[j] = pr[O_CC + tid]; uch[j] = pr[O_CH + tid];
        }
      }
      PIN8(y0); PIN8(y1); PIN8(sf); PIN8(sb); PIN8(a0); PIN8(a1); PIN8(a2); PIN8(a3);
      PIN8(vc); PIN8(vp); PIN8(vn); PIN8(g0r); PIN8(g1r); PIN8(cbr); PIN8(ucc); PIN8(uch);
      asm volatile("" : "+v"(ucc[4]), "+v"(ucc[5]), "+v"(uch[4]), "+v"(uch[5]));
      {
        float gate[4];
#pragma unroll
        for (int i = 0; i < 4; ++i) gate[i] = 0.f;
#pragma unroll
        for (int m = 0; m < 96; m += 4) {
#pragma unroll
          for (int i = 0; i < 4; ++i) {
            float4 s = *reinterpret_cast<const float4*>(sig + (i0 + i) * 96 + m);
            gate[i] += s.x * g2r[m] + s.y * g2r[m + 1] + s.z * g2r[m + 2] + s.w * g2r[m + 3];
          }
        }
#pragma unroll
        for (int i = 0; i < 4; ++i) {
          int row = r0 + i0 + i, t = tb + i0 + i;
          float yv = bf2f((u16)y0[i]) + bf2f((u16)y1[i]);
          float mean = wave_sum_b(yv) * (1.f / 64.f);
          float d = yv - mean;
          float var = wave_sum_b(d * d) * (1.f / 64.f);
          float yn = d * rsqrtf(var + 64e-5f) * gnw + gnb;
          float v_c = bf2f((u16)vc[i]), v_p = t > 0 ? bf2f((u16)vp[i]) : 0.f, v_n = t < T - 1 ? bf2f((u16)vn[i]) : 0.f;
          float vf = v_c + (v_p - v_c) * muvf, vb = v_c + (v_n - v_c) * muvb;
          float bonus = sf[i] * vf + sb[i] * vb;
          p.nbuf[(size_t)row * D + 1536 + tid] = f2bf((yn + bonus) * gate[i]);
        }
      }
#pragma unroll
      for (int i = 0; i < 4; ++i) {
        int row = r0 + i0 + i;
        float o0 = bf2f((u16)a0[i]) + bf2f((u16)a1[i]), o1 = bf2f((u16)a2[i]) + bf2f((u16)a3[i]);
        float ss = wave_sum_b(o0 * o0 + o1 * o1);
        float rstd = rsqrtf(ss * (1.f / 128.f) + 1e-6f);
        u16* dst = p.nbuf + (size_t)row * D + mixer * 512 + hh * 128 + lane;
        dst[0] = f2bf(o0 * rstd * ng0 * siluf_(bf2f((u16)g0r[i])));
        dst[64] = f2bf(o1 * rstd * ng1 * siluf_(bf2f((u16)g1r[i])));
      }
#pragma unroll
      for (int i = 0; i < 4; ++i) {
        int tr = (tb + i0 + i) & (RL - 1);
        float up = tr != 0 ? bf2f((u16)ucc[i]) * bf2f((u16)uch[i]) : 0.f;
        float uc = bf2f((u16)ucc[i + 1]) * bf2f((u16)uch[i + 1]);
        float un = tr != RL - 1 ? bf2f((u16)ucc[i + 2]) * bf2f((u16)uch[i + 2]) : 0.f;
        float cv = scw0 * up + scw1 * uc + scw2 * un;
        p.nbuf[(size_t)(r0 + i0 + i) * D + 1024 + tid] = f2bf(bf2f((u16)cbr[i]) * cv);
      }
    }
#undef PIN8
  }
}

#define XB_TMO      128
#define XB_XCNT(j)  (256  + 64 * (j))
#define XB_XSUB(j)  (1280 + 64 * (j))
#define XB_XGEN(j)  (2304 + 64 * (j))
#define XB_TOP      3328
#define XB_TOPGEN   3392
#define XCD_BAR_WORDS 3456
#define XB_SPIN_CAP (1u << 18)
__device__ __forceinline__ unsigned xb_ld(unsigned* p) { return __hip_atomic_load(p, __ATOMIC_RELAXED, __HIP_MEMORY_SCOPE_AGENT); }
__device__ __forceinline__ unsigned xb_add(unsigned* p, unsigned v) { return __hip_atomic_fetch_add(p, v, __ATOMIC_RELAXED, __HIP_MEMORY_SCOPE_AGENT); }
__device__ __forceinline__ unsigned xb_xcc_id() { return (unsigned)__builtin_amdgcn_s_getreg((3 << 11) | 20) & 0xFu; }
#define XB_SPIN(cond, bar) do { unsigned _sp = 0; while (cond) { __builtin_amdgcn_s_sleep(1); \
    if ((++_sp & 255u) == 0u) { if (xb_ld(&(bar)[XB_TMO])) break; if (_sp > XB_SPIN_CAP) { atomicAdd(&(bar)[XB_TMO], 1u); break; } } } } while (0)
struct XcdBarrier { unsigned* bar; unsigned x; volatile LAS unsigned* st; };
__device__ __forceinline__ XcdBarrier xcd_barrier_post(unsigned* bar, volatile LAS unsigned* st) {
  XcdBarrier b; b.bar = bar; b.x = xb_xcc_id(); b.st = st;
  if (threadIdx.x == 0) (void)xb_add(&bar[XB_XCNT(b.x)], 1u);
  return b;
}
__device__ __forceinline__ void xcd_barrier_complete(unsigned* bar, unsigned x, unsigned& nloc, unsigned& nx) {
  const unsigned G = gridDim.x * gridDim.y * gridDim.z;
  unsigned sum, cnt, mine, sp = 0u;
  for (;;) {
    sum = 0u; cnt = 0u; mine = 0u;
#pragma unroll
    for (unsigned j = 0; j < 16; ++j) { const unsigned c = xb_ld(&bar[XB_XCNT(j)]); sum += c; cnt += (c > 0u) ? 1u : 0u; mine = (j == x) ? c : mine; }
    if (sum == G) break;
    __builtin_amdgcn_s_sleep(1);
    if ((++sp & 255u) == 0u) { if (xb_ld(&bar[XB_TMO])) break; if (sp > XB_SPIN_CAP) { atomicAdd(&bar[XB_TMO], 1u); break; } }
  }
  nloc = mine > 0u ? mine : 1u; nx = cnt > 0u ? cnt : 1u;
}
__device__ __forceinline__ void xcd_barrier(const XcdBarrier& b) {
  asm volatile("s_waitcnt vmcnt(0)" ::: "memory");
  __syncthreads();
  if (threadIdx.x == 0) {
    unsigned* bar = b.bar;
    __builtin_amdgcn_s_waitcnt(0);
    unsigned nloc = b.st[0], nx = b.st[1];
    if (nloc == 0u) { xcd_barrier_complete(bar, b.x, nloc, nx); b.st[0] = nloc; b.st[1] = nx; }
    const unsigned old = xb_add(&bar[XB_XSUB(b.x)], 1u);
    const unsigned gen = old / nloc;
    if (old + 1u == (gen + 1u) * nloc) {
      __builtin_amdgcn_fence(__ATOMIC_RELEASE, "agent");
      asm volatile("s_waitcnt vmcnt(0)" ::: "memory");
      const unsigned og = xb_add(&bar[XB_TOP], 1u);
      const unsigned tg = og / nx;
      if (og + 1u == (tg + 1u) * nx) xb_add(&bar[XB_TOPGEN], 1u);
      else XB_SPIN(xb_ld(&bar[XB_TOPGEN]) == tg, bar);
      __builtin_amdgcn_fence(__ATOMIC_ACQUIRE, "agent");
      xb_add(&bar[XB_XGEN(b.x)], 1u);
      asm volatile("s_waitcnt vmcnt(0)" ::: "memory");
    } else {
      XB_SPIN(xb_ld(&bar[XB_XGEN(b.x)]) == gen, bar);
      __builtin_amdgcn_fence(__ATOMIC_ACQUIRE, "agent");
      asm volatile("s_waitcnt vmcnt(0)" ::: "memory");
    }
  }
  __syncthreads();
}

constexpr int NPH = 20;
__device__ void run_phase(const P& p, int ph, char* shm) {
  float* lf = reinterpret_cast<float*>(shm);
  LAS unsigned char* ll = (LAS unsigned char*)shm;
  if (ph == 0) { phase_mod(p, lf); __syncthreads(); phase_convert(p, 0, lf, blockIdx.x, gridDim.x); return; }
  if (ph == 19) { phase_norm(p, 1, 2, NX); return; }
  const int l = (ph - 1) / 9, s = (ph - 1) % 9;
  const int mtok = (l == 1) ? NX : NT;
  switch (s) {
    case 0: if (l > 0) phase_convert(p, l, lf, blockIdx.x, gridDim.x); phase_norm(p, l, 0, NT); break;
    case 1: { EpiProj E{p.projb}; gemm_phase(ll, p.nbuf, p.wt_in, NT, PROJP, D, E); } break;
    case 2: phase_gdnprep(p, l, lf); break;
    case 3: phase_scan(p, l, (LAS char*)shm); break;
    case 4: phase_combine(p, l, mtok, lf); break;
    case 5: { EpiRes E{l == 0 ? p.x : nullptr, l == 0 ? p.ctx : nullptr, p.out, p.hc, p.mod + (size_t)l * 5 * 6 * D + 2 * D};
              gemm_phase(ll, p.nbuf, p.wt_out, mtok, D, D, E); } break;
    case 6: phase_norm(p, l, 1, mtok); break;
    case 7: { EpiGU E{p.projb}; gemm_phase(ll, p.nbuf, p.wt_gu, mtok, 2 * FFN, D, E); } break;
    case 8: { EpiRes E{nullptr, nullptr, p.out, p.hc, p.mod + (size_t)l * 5 * 6 * D + 5 * D};
              gemm_phase(ll, p.projb, p.wt_down, mtok, D, FFN, E); } break;
  }
}

__global__ void __launch_bounds__(NTHR, 2) mega(P p, int ph0, int ph1) {
  extern __shared__ __attribute__((aligned(16))) char shm[];
  volatile LAS unsigned* xst = (volatile LAS unsigned*)((LAS char*)shm + LDS_TOTAL - 16);
  if (threadIdx.x < 4) xst[threadIdx.x] = 0u;
  __syncthreads();
  XcdBarrier xb = xcd_barrier_post(p.bar, xst);
  for (int ph = ph0; ph < ph1; ++ph) {
    int nrep = 1;
#ifdef DUPMASK
    if ((DUPMASK >> ph) & 1) nrep = 2;
#endif
#pragma unroll 1
    for (int rep = 0; rep < nrep; ++rep) {
      run_phase(p, ph, shm);
      if (rep + 1 < nrep) xcd_barrier(xb);
    }
    if (ph + 1 < ph1) {
      if (ph == ph0) cg::this_grid().sync(); else xcd_barrier(xb);
    }
#ifdef PROBE_XSYNC
    if (ph == 5) { for (int q = 0; q < 20; ++q) xcd_barrier(xb); }
#endif
  }
}

extern "C" void kernel_launch(void* const* d_in, const int* in_sizes, int n_in, void* d_out, int out_size, void* d_ws,
                              size_t ws_size, hipStream_t stream) {
  P p{};
  const float** pf = reinterpret_cast<const float**>(&p);
  for (int i = 0; i < 33; ++i) pf[i] = (const float*)d_in[i];
  p.out = (float*)d_out;
  char* w = (char*)d_ws;
  size_t off = 0;
  auto take = [&](size_t bytes) { char* r = w + off; off += (bytes + 255) & ~(size_t)255; return r; };
  p.wt_in = (u16*)take((size_t)PROJP * D * 2);
  p.wt_out = (u16*)take((size_t)D * D * 2);
  p.wt_gu = (u16*)take((size_t)2 * FFN * D * 2);
  p.wt_down = (u16*)take((size_t)D * FFN * 2);
  p.nbuf = (u16*)take((size_t)NT * D * 2);
  p.projb = (u16*)take((size_t)NT * PROJP * 2);
  p.mod = (float*)take((size_t)2 * 5 * 6 * D * 4);
  p.hc = (float*)take((size_t)NC * D * 4);
  p.osc = (float*)take((size_t)6 * NT * 512 * 2);
  p.sbon = (float*)take((size_t)2 * NT * 8 * 4);
  p.bar = (unsigned*)take((size_t)XCD_BAR_WORDS * 4);
  p.rwd = (float*)take((size_t)2 * NT * 512 * 4);
  p.rwa = (float*)take((size_t)2 * NT * 512 * 4);
  p.kqa = (float*)take((size_t)NT * 8 * 4);
  p.glf = (float*)take((size_t)2 * NT * 256 * 4);
  p.gab = (float*)take((size_t)2 * NT * 8 * 4);
  static int grid_blocks = 0;
  if (!grid_blocks) {
    hipFuncSetAttribute((const void*)mega, hipFuncAttributeMaxDynamicSharedMemorySize, LDS_TOTAL);
    int dev = 0, cus = 0, per_cu = 0;
    hipGetDevice(&dev);
    hipDeviceGetAttribute(&cus, hipDeviceAttributeMultiprocessorCount, dev);
    hipOccupancyMaxActiveBlocksPerMultiprocessor(&per_cu, mega, NTHR, LDS_TOTAL);
    if (per_cu < 1) per_cu = 1;
    grid_blocks = cus * 1;
  }
  hipMemsetAsync(p.bar, 0, (size_t)XCD_BAR_WORDS * 4, stream);
#if MEGA
  int ph0 = 0, ph1 = NPH;
  void* args[] = {&p, &ph0, &ph1};
  hipError_t e = hipLaunchCooperativeKernel((void*)mega, dim3(grid_blocks), dim3(NTHR), args, LDS_TOTAL, stream);
  if (e != hipSuccess) fprintf(stderr, "cooperative launch failed: %s (grid %d)\n", hipGetErrorString(e), grid_blocks);
#else
  for (int ph = 0; ph < NPH; ++ph) mega<<<grid_blocks, NTHR, LDS_TOTAL, stream>>>(p, ph, ph + 1);
#endif
}
```

```cpp
#include <hip/hip_runtime.h>
#include <hip/hip_bf16.h>
#include <hip/hip_cooperative_groups.h>
#include <cstdio>
namespace cg = cooperative_groups;
typedef unsigned short u16;
using bf16x8 = __attribute__((ext_vector_type(8))) short;
using f32x4 = __attribute__((ext_vector_type(4))) float;

#ifndef PROBE_NSTEP
#define PROBE_NSTEP 1
#endif
#ifndef PROBE_NPREP
#define PROBE_NPREP 1
#endif
#ifndef PROBE_NSTEP_RW
#define PROBE_NSTEP_RW PROBE_NSTEP
#endif
#ifndef PROBE_NPREP_RW
#define PROBE_NPREP_RW PROBE_NPREP
#endif
#ifndef MEGA
#define MEGA 1
#endif

constexpr int D = 2048, NB = 4, SEQ = 4096, CTX = 256;
constexpr int NX = NB * SEQ, NC = NB * CTX, NT = NX + NC;
constexpr int PROJ = 6848, PROJP = 6912, FFN = 5632;
constexpr int O_GQ = 0, O_GK = 256, O_GV = 512, O_GR = 1024, O_GLO = 1536;
constexpr int O_DQKV = 1552, O_DZ = 3088, O_DA = 3600, O_DB = 3608;
constexpr int O_CB = 3616, O_CC = 4128, O_CH = 4640;
constexpr int O_RKV = 5152, O_RWA = 6688, O_RG = 6752;
constexpr int NTHR = 512;
constexpr int SHM_BYTES = 131072;
constexpr int TC = 32;

struct P {
  const float *x, *c, *ctx, *c_ctx, *ada_w, *ada_b, *norm1_g, *norm2_g, *w_in, *w_out,
      *gla_a_up, *gla_a_b, *gla_norm_g, *gdn_conv, *gdn_a_log, *gdn_dt_bias, *gdn_norm_g, *sc_conv,
      *rw_mu_rkv, *rw_mu_wa, *rw_w0, *rw_w2, *rw_a0, *rw_a2, *rw_g2, *rw_kk, *rw_ka, *rw_rk,
      *rw_gn_w, *rw_gn_b, *ffn_w_gu, *ffn_w_down, *final_g;
  float* out;
  u16 *wt_in, *wt_out, *wt_gu, *wt_down, *nbuf, *projb;
  float *mod, *hc, *osc, *sbon;
  unsigned* bar;
  float *rwd, *rwa;
  float *kqa;
  float *glf, *gab;
};

__device__ __forceinline__ float bf2f(u16 v) { return __uint_as_float(((unsigned)v) << 16); }
__device__ __forceinline__ u16 f2bf(float f) {
  unsigned u = __float_as_uint(f);
  u += 0x7fffu + ((u >> 16) & 1u);
  return (u16)(u >> 16);
}
__device__ __forceinline__ float sigmoidf_(float x) { return 1.f / (1.f + __expf(-x)); }
__device__ __forceinline__ float siluf_(float x) { return x / (1.f + __expf(-x)); }
__device__ __forceinline__ float tanhf_(float x) { return 1.f - 2.f / (1.f + __expf(2.f * x)); }
__device__ __forceinline__ float softplusf_(float x) { return fmaxf(x, 0.f) + log1pf(__expf(-fabsf(x))); }
template <int CTRL> __device__ __forceinline__ float dpp_f(float v) {
  return __int_as_float(__builtin_amdgcn_mov_dpp(__float_as_int(v), CTRL, 0xf, 0xf, true));
}
__device__ __forceinline__ float red8(float v) {
  v += dpp_f<0xB1>(v); v += dpp_f<0x4E>(v); v += dpp_f<0x141>(v); return v;
}
__device__ __forceinline__ float red16(float v) { v = red8(v); v += dpp_f<0x140>(v); return v; }
__device__ __forceinline__ float wave_sum(float v) {
  v = red16(v); v += __shfl_xor(v, 16); v += __shfl_xor(v, 32); return v;
}
__device__ __forceinline__ float rdlane(float v, int l) {
  return __int_as_float(__builtin_amdgcn_readlane(__float_as_int(v), l));
}
__device__ __forceinline__ int tokrow(int seq, int b, int t) { return seq ? (b * SEQ + t) : (NX + b * CTX + t); }
__device__ __forceinline__ int condof(int row) { return row < NX ? (row >> 12) : 4; }
__device__ __forceinline__ int TIDX() { int t = threadIdx.x; asm volatile("" : "+v"(t)); return t; }

#define LBAR() do { asm volatile("s_waitcnt lgkmcnt(0)" ::: "memory"); __builtin_amdgcn_s_barrier(); asm volatile("" ::: "memory"); } while (0)

__device__ void phase_mod(const P& p, float* lds) {
  float* scond = lds;
  float* red = lds + 5 * D;
  const int tid = TIDX();
  for (int e = tid; e < 5 * D; e += NTHR) {
    int cnd = e / D, k = e % D;
    float v = cnd < 4 ? p.c[cnd * D + k] : p.c_ctx[k];
    scond[e] = siluf_(v);
  }
  __syncthreads();
  const int c4 = tid & 31, kg = tid >> 5;
  for (int tile = blockIdx.x; tile < 2 * 96; tile += gridDim.x) {
    int l = tile / 96, n0 = (tile % 96) * 128;
    float acc[5][4];
#pragma unroll
    for (int a = 0; a < 5; ++a)
#pragma unroll
      for (int j = 0; j < 4; ++j) acc[a][j] = 0.f;
    const float* W = p.ada_w + (size_t)l * D * 6 * D + n0 + c4 * 4;
#pragma unroll 4
    for (int i = 0; i < 128; ++i) {
      int k = kg + 16 * i;
      float4 w = *reinterpret_cast<const float4*>(W + (size_t)k * 6 * D);
#pragma unroll
      for (int a = 0; a < 5; ++a) {
        float s = scond[a * D + k];
        acc[a][0] += s * w.x; acc[a][1] += s * w.y; acc[a][2] += s * w.z; acc[a][3] += s * w.w;
      }
    }
#pragma unroll
    for (int a = 0; a < 5; ++a)
#pragma unroll
      for (int j = 0; j < 4; ++j) red[(kg * 5 + a) * 128 + c4 * 4 + j] = acc[a][j];
    __syncthreads();
    for (int e = tid; e < 5 * 128; e += NTHR) {
      int a = e / 128, cc = e % 128;
      float s = 0.f;
#pragma unroll
      for (int g = 0; g < 16; ++g) s += red[(g * 5 + a) * 128 + cc];
      p.mod[((size_t)l * 5 + a) * 6 * D + n0 + cc] = s + p.ada_b[(size_t)l * 6 * D + n0 + cc];
    }
    __syncthreads();
  }
}

template <int MAP>
__device__ void conv_tiles(const float* src, int K, int Nsrc, u16* dst, int Ndst, float* lds, int& cursor, int vblk, int nblk_total) {
  const int tid = TIDX();
  const int nkt = K / 64, nnt = Ndst / 64, ntile = nkt * nnt;
  float* tile = lds;
  const int kr = tid >> 4, c4 = tid & 15;
  const int n = tid >> 3, kc = tid & 7;
  int first = (vblk - cursor % nblk_total + nblk_total) % nblk_total;
  float4 v0 = make_float4(0.f, 0.f, 0.f, 0.f), v1 = v0;
#define CONV_LOAD(TI, A0, A1) do { \
    int kt_ = (TI) % nkt, nt_ = (TI) / nkt; \
    int nd_ = nt_ * 64 + c4 * 4, ns_; bool valid_ = true; \
    if (MAP == 0) ns_ = nd_; \
    else if (MAP == 1) { valid_ = nd_ < PROJ; ns_ = valid_ ? nd_ : 0; } \
    else { int pn_ = nd_ >> 8, r_ = nd_ & 255; ns_ = (r_ >> 7) * FFN + pn_ * 128 + (r_ & 127); } \
    const float* s_ = src + (size_t)(kt_ * 64 + kr) * Nsrc + ns_; \
    A0 = *reinterpret_cast<const float4*>(s_); A1 = *reinterpret_cast<const float4*>(s_ + (size_t)32 * Nsrc); \
    if (MAP == 1 && !valid_) { A0 = make_float4(0.f, 0.f, 0.f, 0.f); A1 = A0; } } while (0)
  if (first < ntile) CONV_LOAD(first, v0, v1);
  for (int tI = first; tI < ntile; tI += nblk_total) {
    int kt = tI % nkt, nt = tI / nkt;
    int k0 = kt * 64, n0 = nt * 64;
    tile[kr * 65 + c4 * 4 + 0] = v0.x; tile[kr * 65 + c4 * 4 + 1] = v0.y; tile[kr * 65 + c4 * 4 + 2] = v0.z; tile[kr * 65 + c4 * 4 + 3] = v0.w;
    tile[(kr + 32) * 65 + c4 * 4 + 0] = v1.x; tile[(kr + 32) * 65 + c4 * 4 + 1] = v1.y; tile[(kr + 32) * 65 + c4 * 4 + 2] = v1.z; tile[(kr + 32) * 65 + c4 * 4 + 3] = v1.w;
    if (tI + nblk_total < ntile) CONV_LOAD(tI + nblk_total, v0, v1);
    LBAR();
    {
      bf16x8 o;
#pragma unroll
      for (int j = 0; j < 8; ++j) o[j] = (short)f2bf(tile[(kc * 8 + j) * 65 + n]);
      *reinterpret_cast<bf16x8*>(dst + (size_t)(n0 + n) * K + k0 + kc * 8) = o;
    }
    LBAR();
  }
#undef CONV_LOAD
  cursor += ntile;
}
__device__ void phase_convert(const P& p, int l, float* lds, int vblk, int nb) {
  int cursor = 0;
  u16* wi = p.wt_in; u16* wo = p.wt_out; u16* wg = p.wt_gu; u16* wd = p.wt_down;
  conv_tiles<1>(p.w_in + (size_t)l * D * PROJ, D, PROJ, wi, PROJP, lds, cursor, vblk, nb);
  conv_tiles<0>(p.w_out + (size_t)l * D * D, D, D, wo, D, lds, cursor, vblk, nb);
  conv_tiles<2>(p.ffn_w_gu + (size_t)l * D * 2 * FFN, D, 2 * FFN, wg, 2 * FFN, lds, cursor, vblk, nb);
  conv_tiles<0>(p.ffn_w_down + (size_t)l * FFN * D, FFN, D, wd, D, lds, cursor, vblk, nb);
}

__device__ void phase_norm(const P& p, int l, int which, int ntok) {
  const int tid = TIDX(), lane = tid & 63, wv = tid >> 6;
  const int gw = blockIdx.x * 8 + wv, nw = gridDim.x * 8;
  const int per = (ntok + nw - 1) / nw;
  const int rbeg = gw * per, rend = min(ntok, rbeg + per);
  if (rbeg >= rend) return;
  const bool first_in = (l == 0 && which == 0);
  auto rowsrc = [&](int row) -> const float* {
    if (row < NX) return first_in ? p.x + (size_t)row * D : p.out + (size_t)row * D;
    return first_in ? p.ctx + (size_t)(row - NX) * D : p.hc + (size_t)(row - NX) * D;
  };
  float4 gs[8], hh[8];
  int cur_cond = -1;
  float4 v[8], vn[8];
  {
    const float* s0 = rowsrc(rbeg);
#pragma unroll
    for (int i = 0; i < 8; ++i) vn[i] = *reinterpret_cast<const float4*>(s0 + i * 256 + lane * 4);
  }
#pragma unroll 1
  for (int row = rbeg; row < rend; ++row) {
#pragma unroll
    for (int i = 0; i < 8; ++i) v[i] = vn[i];
    if (row + 1 < rend) {
      const float* s1 = rowsrc(row + 1);
#pragma unroll
      for (int i = 0; i < 8; ++i) vn[i] = *reinterpret_cast<const float4*>(s1 + i * 256 + lane * 4);
    }
    const int cnd = which == 2 ? 0 : condof(row);
    if (cnd != cur_cond) {
      cur_cond = cnd;
      if (which == 2) {
#pragma unroll
        for (int i = 0; i < 8; ++i) { gs[i] = *reinterpret_cast<const float4*>(p.final_g + i * 256 + lane * 4); hh[i] = make_float4(0.f, 0.f, 0.f, 0.f); }
      } else {
        const float* gg = (which == 0 ? p.norm1_g : p.norm2_g) + (size_t)l * D;
        const float* md = p.mod + ((size_t)l * 5 + cnd) * 6 * D;
        const float* sh = md + (which == 0 ? 0 : 3) * D;
        const float* sc = md + (which == 0 ? 1 : 4) * D;
#pragma unroll
        for (int i = 0; i < 8; ++i) {
          int cc = i * 256 + lane * 4;
          float4 g = *reinterpret_cast<const float4*>(gg + cc);
          float4 s = *reinterpret_cast<const float4*>(sc + cc);
          hh[i] = *reinterpret_cast<const float4*>(sh + cc);
          gs[i] = make_float4(g.x * (1.f + s.x), g.y * (1.f + s.y), g.z * (1.f + s.z), g.w * (1.f + s.w));
        }
      }
    }
    float ss = 0.f;
#pragma unroll
    for (int i = 0; i < 8; ++i) ss += v[i].x * v[i].x + v[i].y * v[i].y + v[i].z * v[i].z + v[i].w * v[i].w;
    ss = wave_sum(ss);
    float rstd = rsqrtf(ss * (1.f / D) + 1e-6f);
    if (which == 2) {
#pragma unroll
      for (int i = 0; i < 8; ++i) {
        int cc = i * 256 + lane * 4;
        float4 o = make_float4(v[i].x * rstd * gs[i].x, v[i].y * rstd * gs[i].y, v[i].z * rstd * gs[i].z, v[i].w * rstd * gs[i].w);
        *reinterpret_cast<float4*>(p.out + (size_t)row * D + cc) = o;
      }
    } else {
#pragma unroll
      for (int i = 0; i < 8; ++i) {
        int cc = i * 256 + lane * 4;
        ushort4 o;
        o.x = f2bf(v[i].x * rstd * gs[i].x + hh[i].x);
        o.y = f2bf(v[i].y * rstd * gs[i].y + hh[i].y);
        o.z = f2bf(v[i].z * rstd * gs[i].z + hh[i].z);
        o.w = f2bf(v[i].w * rstd * gs[i].w + hh[i].w);
        *reinterpret_cast<ushort4*>(p.nbuf + (size_t)row * D + cc) = o;
      }
    }
  }
}

#define LAS __attribute__((address_space(3)))
typedef unsigned u32x4 __attribute__((ext_vector_type(4)));
constexpr int BM = 256, BK = 64, HALF = 128, HTB = HALF * BK * 2, NXCD = 8, WGM = 8;
__device__ __forceinline__ int lds_byte(int r, int c) {
  const int st = (r >> 4) * 2 + (c >> 5), rr = r & 15, cc = c & 31, ob = rr * 64 + cc * 2;
  return st * 1024 + (ob ^ (((ob >> 9) & 1) << 5));
}
__device__ __forceinline__ void stage_rc(int b, int& R, int& C) {
  const int st = b / 1024, sb = b % 1024, swz = sb ^ (((sb >> 9) & 1) << 5);
  R = (st >> 1) * 16 + swz / 64; C = (st & 1) * 32 + (swz % 64) / 2;
}
struct Unit { int pm, pn; };
struct StaticOrder {
  int nM, nN, nwg, G, c;
  __device__ void init(int M, int N, int G_, int c_) { nM = M / BM; nN = N / BM; nwg = nM * nN; G = G_; c = c_; }
  __device__ bool next(int i, Unit& u) const {
    const long L = (long)i * G + c; if (L >= nwg) return false;
    int wgid = (int)L;
    { const int q = nwg / NXCD, r = nwg % NXCD, xcd = wgid % NXCD, off = wgid / NXCD; wgid = (xcd < r ? xcd * (q + 1) : r * (q + 1) + (xcd - r) * q) + off; }
    const int nig = WGM * nN, gid = wgid / nig, fm = gid * WGM, gsz = (nM - fm) < WGM ? (nM - fm) : WGM;
    u.pm = fm + ((wgid % nig) % gsz); u.pn = (wgid % nig) / gsz; return true;
  }
};
__device__ __forceinline__ unsigned pk_bf16(float lo, float hi) { return (unsigned)f2bf(lo) | ((unsigned)f2bf(hi) << 16); }

struct EpiProj {
  u16* O;
  __device__ __forceinline__ void operator()(const f32x4 (&acc)[2][2][4][2], const Unit& u, int wr, int wc, int fr, int fq) const {
    const int row0 = u.pm * BM + wr * 64 + fr, col0 = u.pn * BM + wc * 32 + 4 * fq;
#pragma unroll
    for (int ai = 0; ai < 2; ++ai)
#pragma unroll
      for (int m = 0; m < 4; ++m) {
        u16* rowp = O + (size_t)(row0 + ai * HALF + m * 16) * PROJP + col0;
#pragma unroll
        for (int bj = 0; bj < 2; ++bj)
#pragma unroll
          for (int n = 0; n < 2; ++n) {
            f32x4 v = acc[ai][bj][m][n];
            uint2 w; w.x = pk_bf16(v[0], v[1]); w.y = pk_bf16(v[2], v[3]);
            *reinterpret_cast<uint2*>(rowp + bj * HALF + n * 16) = w;
          }
      }
  }
};
struct EpiGU {
  u16* O;
  __device__ __forceinline__ void operator()(const f32x4 (&acc)[2][2][4][2], const Unit& u, int wr, int wc, int fr, int fq) const {
    const int row0 = u.pm * BM + wr * 64 + fr, col0 = u.pn * HALF + wc * 32 + 4 * fq;
#pragma unroll
    for (int ai = 0; ai < 2; ++ai)
#pragma unroll
      for (int m = 0; m < 4; ++m) {
        u16* rowp = O + (size_t)(row0 + ai * HALF + m * 16) * FFN + col0;
#pragma unroll
        for (int n = 0; n < 2; ++n) {
          f32x4 g = acc[ai][0][m][n], up = acc[ai][1][m][n];
          uint2 w;
          w.x = pk_bf16(siluf_(g[0]) * up[0], siluf_(g[1]) * up[1]);
          w.y = pk_bf16(siluf_(g[2]) * up[2], siluf_(g[3]) * up[3]);
          *reinterpret_cast<uint2*>(rowp + n * 16) = w;
        }
      }
  }
};
struct EpiRes {
  const float* xin; const float* cin;
  float* out; float* hc; const float* gate;
  __device__ __forceinline__ void operator()(const f32x4 (&acc)[2][2][4][2], const Unit& u, int wr, int wc, int fr, int fq) const {
    const int row0 = u.pm * BM + wr * 64 + fr, col0 = u.pn * BM + wc * 32 + 4 * fq;
#pragma unroll
    for (int ai = 0; ai < 2; ++ai)
#pragma unroll
      for (int m = 0; m < 4; ++m) {
        const int row = row0 + ai * HALF + m * 16;
        const float* gp = gate + (size_t)condof(row) * 6 * D + col0;
        const float* hold; float* hnew;
        if (row < NX) { hnew = out + (size_t)row * D + col0; hold = xin ? xin + (size_t)row * D + col0 : hnew; }
        else { hnew = hc + (size_t)(row - NX) * D + col0; hold = cin ? cin + (size_t)(row - NX) * D + col0 : hnew; }
#pragma unroll
        for (int bj = 0; bj < 2; ++bj)
#pragma unroll
          for (int n = 0; n < 2; ++n) {
            f32x4 h = *reinterpret_cast<const f32x4*>(hold + bj * HALF + n * 16);
            f32x4 g = *reinterpret_cast<const f32x4*>(gp + bj * HALF + n * 16);
            *reinterpret_cast<f32x4*>(hnew + bj * HALF + n * 16) = h + g * acc[ai][bj][m][n];
          }
      }
  }
};

template <class Epi>
__device__ __forceinline__ void gemm_phase(LAS unsigned char* lds, const u16* gA, const u16* gBt, int M, int N, int K, const Epi& E) {
  const int tid = TIDX(), wid = __builtin_amdgcn_readfirstlane(tid >> 6), lane = tid & 63, wr = wid >> 2, wc = wid & 3, fr = lane & 15, fq = lane >> 4;
  const int nt = K / BK;
  StaticOrder S; S.init(M, N, gridDim.x, blockIdx.x);
  unsigned voffA[2], voffB[2];
#pragma unroll
  for (int i = 0; i < 2; ++i) { int R, C; stage_rc(tid * 16 + i * 8192, R, C); voffA[i] = (unsigned)(R * K + C) * 2u; voffB[i] = voffA[i]; }
  const size_t kstep = (size_t)(BK * 2);
  const size_t hstep = (size_t)HALF * K * 2;
  const size_t tstep = 2 * hstep;
  const unsigned ldsw = (unsigned)wid * 1024u;
  const int aoff = lds_byte(wr * 64 + fr, fq * 8), boff = lds_byte(wc * 32 + fr, fq * 8);
#define G_SA(b, h) (((b) * 2 + (h)) * HTB)
#define G_SB(b, h) ((4 + (b) * 2 + (h)) * HTB)
#define G_STAGE(bufoff, gbase, voff) do { _Pragma("unroll") for (int _i = 0; _i < 2; ++_i) \
    __builtin_amdgcn_global_load_lds((const unsigned*)((const char*)(gbase) + (voff)[_i]), (LAS unsigned*)(lds + (bufoff) + ldsw + _i * 8192), 16, 0, 0); } while (0)
#define G_LDA(dst, b, h) do { _Pragma("unroll") for (int m = 0; m < 4; ++m) _Pragma("unroll") for (int k = 0; k < 2; ++k) dst[m][k] = *(const LAS bf16x8*)(lds + G_SA(b, h) + aoff + m * 2048 + k * 1024); } while (0)
#define G_LDB(dst, b, h) do { _Pragma("unroll") for (int n = 0; n < 2; ++n) _Pragma("unroll") for (int k = 0; k < 2; ++k) dst[n][k] = *(const LAS bf16x8*)(lds + G_SB(b, h) + boff + n * 2048 + k * 1024); } while (0)
#define G_MMA(ai, bj, At, Bt) do { __builtin_amdgcn_s_setprio(1); _Pragma("unroll") for (int m = 0; m < 4; ++m) _Pragma("unroll") for (int n = 0; n < 2; ++n) _Pragma("unroll") for (int k = 0; k < 2; ++k) \
    acc[ai][bj][m][n] = __builtin_amdgcn_mfma_f32_16x16x32_bf16(Bt[n][k], At[m][k], acc[ai][bj][m][n], 0, 0, 0); __builtin_amdgcn_s_setprio(0); } while (0)
#define G_WAIT_V(n) asm volatile("s_waitcnt vmcnt(" #n ")" ::: "memory")
#define G_WAIT_L(n) asm volatile("s_waitcnt lgkmcnt(" #n ")" ::: "memory")
#define G_BAR __builtin_amdgcn_s_barrier()
#define G_SCHED __builtin_amdgcn_sched_barrier(0)
  Unit cur, nxt; int ui = 0;
  if (!S.next(0, cur)) return;
  f32x4 acc[2][2][4][2];
#pragma unroll
  for (int a = 0; a < 2; ++a)
#pragma unroll
    for (int b = 0; b < 2; ++b)
#pragma unroll
      for (int m = 0; m < 4; ++m)
#pragma unroll
        for (int n = 0; n < 2; ++n) acc[a][b][m][n] = (f32x4){0.f, 0.f, 0.f, 0.f};
  bf16x8 At[4][2], B0[2][2], B1[2][2];
  const char* cA = (const char*)gA + (size_t)cur.pm * tstep; const char* cB = (const char*)gBt + (size_t)cur.pn * tstep;
  G_STAGE(G_SB(0, 0), cB, voffB); G_STAGE(G_SA(0, 0), cA, voffA); G_STAGE(G_SB(0, 1), cB + hstep, voffB); G_STAGE(G_SA(0, 1), cA + hstep, voffA);
  if (wr == 1) G_BAR;
  G_WAIT_V(4); G_BAR;
  G_STAGE(G_SB(1, 0), cB + kstep, voffB); G_STAGE(G_SA(1, 0), cA + kstep, voffA); G_STAGE(G_SB(1, 1), cB + hstep + kstep, voffB);
  G_WAIT_V(6); G_BAR;
  for (;;) {
    const bool has_next = S.next(ui + 1, nxt);
    const char* nA = has_next ? (const char*)gA + (size_t)nxt.pm * tstep : cA; const char* nB = has_next ? (const char*)gBt + (size_t)nxt.pn * tstep : cB;
    for (int t = 0; t < nt; t += 2) {
      const bool last = (t == nt - 2);
      const char* a1 = cA + (size_t)(t + 1) * kstep;
      const char* a2 = last ? nA : cA + (size_t)(t + 2) * kstep; const char* b2 = last ? nB : cB + (size_t)(t + 2) * kstep;
      const char* a3 = a2 + kstep; const char* b3 = b2 + kstep;
      G_LDB(B0, 0, 0); G_SCHED; G_LDA(At, 0, 0); G_STAGE(G_SA(1, 1), a1 + hstep, voffA);
      G_WAIT_L(8); G_BAR; G_WAIT_L(0); G_MMA(0, 0, At, B0); G_BAR; G_SCHED;
      G_LDB(B1, 0, 1); G_STAGE(G_SB(0, 0), b2, voffB);
      G_BAR; G_WAIT_L(0); G_MMA(0, 1, At, B1); G_BAR;
      G_LDA(At, 0, 1); G_STAGE(G_SA(0, 0), a2, voffA);
      G_BAR; G_WAIT_L(0); G_MMA(1, 0, At, B0); G_BAR; G_SCHED;
      G_STAGE(G_SB(0, 1), b2 + hstep, voffB);
      G_WAIT_V(6); G_BAR; G_MMA(1, 1, At, B1); G_BAR;
      G_LDB(B0, 1, 0); G_SCHED; G_LDA(At, 1, 0); G_STAGE(G_SA(0, 1), a2 + hstep, voffA);
      G_WAIT_L(8); G_BAR; G_WAIT_L(0); G_MMA(0, 0, At, B0); G_BAR; G_SCHED;
      G_LDB(B1, 1, 1); G_STAGE(G_SB(1, 0), b3, voffB);
      G_BAR; G_WAIT_L(0); G_MMA(0, 1, At, B1); G_BAR;
      G_LDA(At, 1, 1); G_STAGE(G_SA(1, 0), a3, voffA);
      G_BAR; G_WAIT_L(0); G_MMA(1, 0, At, B0); G_BAR; G_SCHED;
      G_STAGE(G_SB(1, 1), b3 + hstep, voffB);
      G_WAIT_V(6); G_BAR; G_MMA(1, 1, At, B1); G_BAR;
    }
    E(acc, cur, wr, wc, fr, fq);
    if (!has_next) break;
#pragma unroll
    for (int a = 0; a < 2; ++a)
#pragma unroll
      for (int b = 0; b < 2; ++b)
#pragma unroll
        for (int m = 0; m < 4; ++m)
#pragma unroll
          for (int n = 0; n < 2; ++n) acc[a][b][m][n] = (f32x4){0.f, 0.f, 0.f, 0.f};
    cur = nxt; cA = nA; cB = nB; ++ui;
  }
  G_WAIT_V(0);
  if (wr == 0) G_BAR;
  G_BAR;
}

typedef float f32x2 __attribute__((ext_vector_type(2)));
constexpr int NCHK = CTX / TC + SEQ / TC;
__device__ __forceinline__ u16* osc_ptr(const P& p, int mixer, int dir) { return reinterpret_cast<u16*>(p.osc) + ((size_t)(mixer * 2 + dir)) * NT * 512; }
__device__ __forceinline__ float wave_sum_b(float v) {
  v = red16(v);
  v += __int_as_float(__builtin_amdgcn_update_dpp(0, __float_as_int(v), 0x142, 0xa, 0xf, false));
  v += __int_as_float(__builtin_amdgcn_update_dpp(0, __float_as_int(v), 0x143, 0xc, 0xf, false));
  return rdlane(v, 63);
}
__device__ __forceinline__ void chunk_pos(int g, int& seq, int& T, int& c0) {
  seq = g >= CTX / TC; T = seq ? SEQ : CTX; c0 = (seq ? g - CTX / TC : g) * TC;
}
#define L128(ptr, off) (*(const LAS f32x4*)((ptr) + (off)))
#define L64(ptr, off) (*(const LAS f32x2*)((ptr) + (off)))
#define L32(ptr, off) (*(const LAS float*)((ptr) + (off)))

constexpr int RW_VS = 360, RW_VB = RW_VS * 4;
constexpr int RW_OFF_Y = 2 * TC * RW_VB, RW_OFF_TW = RW_OFF_Y + 2 * TC * 32 * 4, RW_OFF_LW = RW_OFF_TW + 32 * 68 * 4, RW_OFF_LA = RW_OFF_LW + 32 * 68 * 4;
static_assert(RW_OFF_LA + 32 * 68 * 4 <= SHM_BYTES, "rwkv lds");
struct RwRaw { unsigned r[5], k[5], v[5]; float dec[4], av[4]; };
struct RwVec { f32x4 e0, e1, w, a, p; float vv; f32x2 cc; };
__device__ __forceinline__ void rw_load(const P& p, int b, int ch, int lane, int dir, int g, int wv, RwRaw& R) {
  int seq, T, c0; chunk_pos(g, seq, T, c0);
#pragma unroll
  for (int j = 0; j < 5; ++j) {
    int s = c0 + wv * 4 + j - 1;
    s = s < 0 ? 0 : s;
    int t = dir ? T - 1 - s : s;
    const u16* pr = p.projb + (unsigned)(tokrow(seq, b, t) * PROJP);
    R.r[j] = pr[O_RKV + ch]; R.k[j] = pr[O_RKV + 512 + ch]; R.v[j] = pr[O_RKV + 1024 + ch];
    if (j >= 1) {
      const unsigned o = (unsigned)(((size_t)dir * NT + tokrow(seq, b, t)) * 512 + ch);
      R.dec[j - 1] = p.rwd[o]; R.av[j - 1] = p.rwa[o];
    }
  }
}

__device__ void scan_rwkv(const P& p, int l, int b, int h, int dir, int rh, LAS char* lds) {
  const int tid = TIDX(), lane = tid & 63, wv = tid >> 6;
  const int ch = h * 64 + lane;
  const float* mu = p.rw_mu_rkv + ((size_t)l * 2 + dir) * 1536;
  const float mu_r = mu[ch], mu_k = mu[512 + ch], mu_v = mu[1024 + ch];
  const float kkw = p.rw_kk[(size_t)l * 512 + ch], kaw = p.rw_ka[(size_t)l * 512 + ch], rkw = p.rw_rk[(size_t)l * 512 + ch];
  u16* oy = osc_ptr(p, 2, dir);
  float* sb_out = p.sbon + (size_t)dir * NT * 8;
  f32x2 S2[2];
  S2[0] = (f32x2){0.f, 0.f}; S2[1] = (f32x2){0.f, 0.f};
  const int row = tid >> 4, kq = tid & 15;
  RwRaw R;

#define RW_PREP_C(G) do { \
    int seq_, T_, c0_; chunk_pos((G), seq_, T_, c0_); \
    LAS float* vbuf_ = (LAS float*)(lds + ((G) & 1) * TC * RW_VB); \
    _Pragma("unroll") for (int i = 0; i < 4; ++i) { \
      int si = wv * 4 + i, s = c0_ + si; \
      int t = dir ? T_ - 1 - s : s; \
      int rowg = tokrow(seq_, b, t); \
      const bool nop_ = (i == 0) && (wv == 0) && ((G) == 0 || (G) == CTX / TC); \
      float rc_ = bf2f((u16)R.r[i + 1]), kc_ = bf2f((u16)R.k[i + 1]), vc_ = bf2f((u16)R.v[i + 1]); \
      float rp_v = nop_ ? 0.f : bf2f((u16)R.r[i]), kp_v = nop_ ? 0.f : bf2f((u16)R.k[i]), vp_v = nop_ ? 0.f : bf2f((u16)R.v[i]); \
      float r = rc_ + (rp_v - rc_) * mu_r, k = kc_ + (kp_v - kc_) * mu_k, v = vc_ + (vp_v - vc_) * mu_v; \
      float decay = R.dec[i], a = R.av[i];     \
      float ku = k * kkw;                                     \
      float kp = k * (1.f + (a - 1.f) * kaw); \
      float ssq = wave_sum_b(ku * ku), s1 = wave_sum_b(ku * a * r), c2 = wave_sum_b(kp * r), sb = wave_sum_b(r * kp * rkw); \
      float rsq = rsqrtf(ssq + 1e-6f); \
      float kk = ku * rsq; \
      float kka = kk * a; \
      float c1 = rsq * s1; \
      if (lane == 0 && rh == 0) sb_out[(unsigned)(rowg * 8 + h)] = sb; \
      LAS float* vb = vbuf_ + si * RW_VS; \
      *(LAS f32x2*)(vb + 2 * lane + (lane >> 5) * 4) = (f32x2){kk, decay * r}; \
      vb[132 + lane] = decay; vb[196 + lane] = kka; vb[260 + lane] = kp; \
      if ((lane >> 5) == rh) vb[324 + (lane & 31)] = v; \
      if (lane == 0) *(LAS f32x2*)(vb + 356) = (f32x2){c1, c2}; \
    } } while (0)
#define RW_LDV(V, j_) do { \
    V.e0 = L128(bp, (j_) * RW_VB); V.e1 = L128(bp, (j_) * RW_VB + 16); V.w = L128(bq, (j_) * RW_VB + 528); V.a = L128(bq, (j_) * RW_VB + 784); \
    V.p = L128(bq, (j_) * RW_VB + 1040); V.vv = L32(bv, (j_) * RW_VB + 1296); V.cc = L64(bc, (j_) * RW_VB + 1424); } while (0)
#define RW_PIN(V) asm volatile("" : "+v"(V.e0), "+v"(V.e1), "+v"(V.w), "+v"(V.a), "+v"(V.p), "+v"(V.vv), "+v"(V.cc), "+v"(S2[0]), "+v"(S2[1]))
#define RW_STEP(V, j_) do { \
    f32x2 d = V.e0.xy * S2[0].x; d += V.e0.zw * S2[0].y; d += V.e1.xy * S2[1].x; d += V.e1.zw * S2[1].y; \
    f32x2 t0_ = S2[0] * V.w.xy + V.p.xy * V.vv, t1_ = S2[1] * V.w.zw + V.p.zw * V.vv;     \
    float sa = red16(d.x), yd = red16(d.y); \
    S2[0] = t0_ - V.a.xy * sa; S2[1] = t1_ - V.a.zw * sa; \
    float y_ = yd - sa * V.cc.x + V.vv * V.cc.y; ykeep = (kq == (j_)) ? y_ : ykeep; } while (0)
#define RW_2(jA, jB) RW_LDV(B, jA + 1); __builtin_amdgcn_sched_barrier(0); RW_STEP(A, jA); RW_PIN(B); \
                     RW_LDV(A, jB + 1); __builtin_amdgcn_sched_barrier(0); RW_STEP(B, jB); RW_PIN(A);

  rw_load(p, b, ch, lane, dir, 0, wv, R);
  RW_PREP_C(0);
  rw_load(p, b, ch, lane, dir, 1, wv, R);
  LBAR();
  for (int g = 0; g < NCHK; ++g) {
    LAS char* vbuf = lds + (g & 1) * TC * RW_VB;
    LAS float* ybuf = (LAS float*)(lds + RW_OFF_Y + (g & 1) * TC * 32 * 4);
    {
      RwVec A, B;
      LAS char* bp = vbuf + kq * 32 + (kq >> 3) * 16; LAS char* bq = vbuf + kq * 16; LAS char* bv = vbuf + row * 4; LAS char* bc = vbuf;
      RW_LDV(A, 0); RW_PIN(A);
#pragma unroll 1
      for (int s16 = 0; s16 < TC; s16 += 16) {
        float ykeep = 0.f;
        RW_2(0, 1) RW_2(2, 3) RW_2(4, 5) RW_2(6, 7) RW_2(8, 9) RW_2(10, 11) RW_2(12, 13) RW_2(14, 15)
        ybuf[(s16 + kq) * 32 + row] = ykeep;
        bp += 16 * RW_VB; bq += 16 * RW_VB; bv += 16 * RW_VB; bc += 16 * RW_VB;
      }
    }
    if (g + 1 < NCHK) RW_PREP_C(g + 1);
    if (g + 2 < NCHK) rw_load(p, b, ch, lane, dir, g + 2, wv, R);
    LBAR();
    {
      int seq, T, c0; chunk_pos(g, seq, T, c0);
      if (!(l == 1 && seq == 0))
#pragma unroll
      for (int q = 0; q < TC * 32 / NTHR; ++q) {
        int e = tid + q * NTHR;
        int si = e >> 5, rr = e & 31, s = c0 + si, t = dir ? T - 1 - s : s;
        oy[(unsigned)(tokrow(seq, b, t) * 512) + h * 64 + rh * 32 + rr] = f2bf(ybuf[e]);
      }
    }
  }
#undef RW_PREP_C
#undef RW_LDV
#undef RW_PIN
#undef RW_STEP
#undef RW_2
}

struct GlRaw { unsigned q[8], k[8], v[8]; float f[8], kq[8]; };
struct GlVec { f32x4 f0, f1, k0, k1, q0, q1; float vv, kq; };
template <int TPW, int NCOL>
__device__ __forceinline__ void gl_load(const P& p, int b, int ch, int vch, int lane, int dir, int g, int wv, GlRaw& R) {
  int seq, T, c0; chunk_pos(g, seq, T, c0);
#pragma unroll
  for (int i = 0; i < TPW; ++i) {
    int s = c0 + wv * TPW + i, t = dir ? T - 1 - s : s;
    const u16* pr = p.projb + (unsigned)(tokrow(seq, b, t) * PROJP);
    R.q[i] = pr[O_GQ + ch]; R.k[i] = pr[O_GK + ch]; R.v[i] = pr[O_GV + vch + (lane & (NCOL - 1))];
    R.f[i] = p.glf[(unsigned)(((size_t)dir * NT + tokrow(seq, b, t)) * 256 + ch)];
    R.kq[i] = p.kqa[(unsigned)(tokrow(seq, b, t) * 8 + 4 + (ch >> 6))];
  }
}
template <int NW>
__device__ void scan_gla(const P& p, int l, int b, int h, int dir, int part, LAS char* lds) {
  constexpr int NCOL = NW * 8, TPW = TC / NW, NTH = NW * 64, GL_VS = 196 + NCOL, GL_VB = GL_VS * 4, GL_OFF_V = 192 * 4, GL_OFF_S = (192 + NCOL) * 4, GL_OFF_Y = 2 * TC * GL_VB;
  const int tid = TIDX(), lane = tid & 63, wv = (tid >> 6) & (NW - 1), tl = tid & (NTH - 1);
  const int ch = h * 64 + lane;
  u16* oo = osc_ptr(p, 0, dir);
  f32x2 S2[4];
#pragma unroll
  for (int i = 0; i < 4; ++i) S2[i] = (f32x2){0.f, 0.f};
  const int col = tl >> 3, dq = tl & 7;
  const int vch = h * 128 + part * NCOL;
  GlRaw R;
#define GL_PREP(G) do { \
    LAS float* vbuf_ = (LAS float*)(lds + ((G) & 1) * TC * GL_VB); \
    _Pragma("unroll") for (int i = 0; i < TPW; ++i) { \
      int si = wv * TPW + i; \
      float q = bf2f((u16)R.q[i]) * 0.125f, k = bf2f((u16)R.k[i]), v = bf2f((u16)R.v[i]), f = R.f[i]; \
      float kq_ = R.kq[i]; \
      LAS float* vb = vbuf_ + si * GL_VS; \
      vb[lane] = f; vb[64 + lane] = k; vb[128 + lane] = f * q; if (lane < NCOL) vb[192 + lane] = v; \
      if (lane == 0) vb[192 + NCOL] = kq_; \
    } } while (0)
#define GL_LDV(V, j_) do { \
    V.f0 = L128(bq, (j_) * GL_VB); V.f1 = L128(bq, (j_) * GL_VB + 16); V.k0 = L128(bq, (j_) * GL_VB + 256); V.k1 = L128(bq, (j_) * GL_VB + 272); \
    V.q0 = L128(bq, (j_) * GL_VB + 512); V.q1 = L128(bq, (j_) * GL_VB + 528); V.vv = L32(bv, (j_) * GL_VB + GL_OFF_V); V.kq = L32(bc, (j_) * GL_VB + GL_OFF_S); } while (0)
#define GL_PIN(V) asm volatile("" : "+v"(V.f0), "+v"(V.f1), "+v"(V.k0), "+v"(V.k1), "+v"(V.q0), "+v"(V.q1), "+v"(V.vv), "+v"(V.kq), "+v"(S2[0]), "+v"(S2[1]), "+v"(S2[2]), "+v"(S2[3]))
#define GL_STEP(V, j_) do { \
    f32x2 o2 = S2[0] * V.q0.xy; o2 += S2[1] * V.q0.zw; o2 += S2[2] * V.q1.xy; o2 += S2[3] * V.q1.zw; \
    S2[0] = S2[0] * V.f0.xy + V.k0.xy * V.vv; S2[1] = S2[1] * V.f0.zw + V.k0.zw * V.vv; \
    S2[2] = S2[2] * V.f1.xy + V.k1.xy * V.vv; S2[3] = S2[3] * V.f1.zw + V.k1.zw * V.vv; \
    float o_ = red8(o2.x + o2.y) + V.vv * V.kq; ykeep = (dq == (j_)) ? o_ : ykeep; } while (0)
#define GL_2(jA, jB) GL_LDV(B, jA + 1); __builtin_amdgcn_sched_barrier(0); GL_STEP(A, jA); GL_PIN(B); \
                     GL_LDV(A, jB + 1); __builtin_amdgcn_sched_barrier(0); GL_STEP(B, jB); GL_PIN(A);
  gl_load<TPW, NCOL>(p, b, ch, vch, lane, dir, 0, wv, R);
  GL_PREP(0);
  gl_load<TPW, NCOL>(p, b, ch, vch, lane, dir, 1, wv, R);
  LBAR();
  for (int g = 0; g < NCHK; ++g) {
    LAS char* vbuf = lds + (g & 1) * TC * GL_VB;
    LAS float* obuf = (LAS float*)(lds + GL_OFF_Y + (g & 1) * TC * NCOL * 4);
    {
      GlVec A, B;
      LAS char* bq = vbuf + dq * 32; LAS char* bv = vbuf + col * 4; LAS char* bc = vbuf;
      GL_LDV(A, 0); GL_PIN(A);
#pragma unroll 1
      for (int s8 = 0; s8 < TC; s8 += 8) {
        float ykeep = 0.f;
        GL_2(0, 1) GL_2(2, 3) GL_2(4, 5) GL_2(6, 7)
        obuf[(s8 + dq) * NCOL + col] = ykeep;
        bq += 8 * GL_VB; bv += 8 * GL_VB; bc += 8 * GL_VB;
      }
    }
    if (g + 1 < NCHK) GL_PREP(g + 1);
    if (g + 2 < NCHK) gl_load<TPW, NCOL>(p, b, ch, vch, lane, dir, g + 2, wv, R);
    LBAR();
    {
      int seq, T, c0; chunk_pos(g, seq, T, c0);
      if (!(l == 1 && seq == 0))
#pragma unroll
      for (int q = 0; q < TC * NCOL / NTH; ++q) {
        int e = tl + q * NTH;
        int si = e / NCOL, cc = e % NCOL, s = c0 + si, t = dir ? T - 1 - s : s;
        oo[(unsigned)(tokrow(seq, b, t) * 512) + vch + cc] = f2bf(obuf[e]);
      }
    }
  }
#undef GL_PREP
#undef GL_LDV
#undef GL_PIN
#undef GL_STEP
#undef GL_2
}

struct GdRaw { unsigned q0[8], q1[8], k0[8], k1[8], v[8]; float2 ab[8]; float kq[8]; };
struct GdVec { f32x4 k0, k1, k2, k3, q0, q1, q2, q3; float vv; f32x4 abk; };
template <int TPW>
__device__ __forceinline__ void gd_load(const P& p, int b, int h, int qc0, int vc, int dir, int g, int wv, GdRaw& R) {
  int seq, T, c0; chunk_pos(g, seq, T, c0);
#pragma unroll
  for (int i = 0; i < TPW; ++i) {
    int s = c0 + wv * TPW + i;
    int t = dir ? T - 1 - s : s;
    int rowg = tokrow(seq, b, t);
    const u16* pq = p.nbuf + (unsigned)(rowg * D);
    R.q0[i] = pq[qc0]; R.q1[i] = pq[qc0 + 64]; R.k0[i] = pq[512 + qc0]; R.k1[i] = pq[512 + qc0 + 64]; R.v[i] = pq[vc];
    R.ab[i] = *reinterpret_cast<const float2*>(p.gab + (((size_t)dir * NT + rowg) * 4 + h) * 2);
    R.kq[i] = p.kqa[(unsigned)(rowg * 8 + h)];
  }
}
template <int NW>
__device__ void scan_gdn(const P& p, int l, int b, int h, int dir, int part, LAS char* lds) {
  constexpr int NCOL = NW * 8, TPW = TC / NW, NTH = NW * 64, GD_VS = 276 + NCOL, GD_VB = GD_VS * 4, GD_OFF_V = 272 * 4, GD_OFF_S = (272 + NCOL) * 4, GD_OFF_Y = 2 * TC * GD_VB;
  const int tid = TIDX(), lane = tid & 63, wv = (tid >> 6) & (NW - 1), tl = tid & (NTH - 1);
  const int qc0 = h * 128 + lane;
  const int vcol = h * 128 + part * NCOL;
  const int vc = 1024 + vcol + (lane & (NCOL - 1));
  u16* oo = osc_ptr(p, 1, dir);
  f32x2 S2[8];
#pragma unroll
  for (int i = 0; i < 8; ++i) S2[i] = (f32x2){0.f, 0.f};
  const int col = tl >> 3, dq = tl & 7;
  float alpha = 1.f;
  GdRaw R;
#define GD_PREP(G) do { \
    LAS float* vbuf_ = (LAS float*)(lds + ((G) & 1) * TC * GD_VB); \
    _Pragma("unroll") for (int i = 0; i < TPW; ++i) { \
      int si = wv * TPW + i; \
      float q0 = bf2f((u16)R.q0[i]), q1 = bf2f((u16)R.q1[i]), k0 = bf2f((u16)R.k0[i]), k1 = bf2f((u16)R.k1[i]), v = bf2f((u16)R.v[i]); \
      float kqd = R.kq[i]; \
      float a = R.ab[i].x, beta = R.ab[i].y;     \
      LAS float* vb = vbuf_ + si * GD_VS; \
      vb[lane] = k0; vb[68 + lane] = k1; vb[136 + lane] = q0; vb[204 + lane] = q1; if (lane < NCOL) vb[272 + lane] = v; \
      { float sv_ = lane == 0 ? a : (lane == 1 ? beta : kqd); if (lane < 3) vb[272 + NCOL + lane] = sv_; } \
    } } while (0)
#define GD_LDV(V, j_) do { \
    V.k0 = L128(bk, (j_) * GD_VB); V.k1 = L128(bk, (j_) * GD_VB + 16); V.k2 = L128(bk, (j_) * GD_VB + 32); V.k3 = L128(bk, (j_) * GD_VB + 48); \
    V.q0 = L128(bk, (j_) * GD_VB + 544); V.q1 = L128(bk, (j_) * GD_VB + 560); V.q2 = L128(bk, (j_) * GD_VB + 576); V.q3 = L128(bk, (j_) * GD_VB + 592); \
    V.vv = L32(bv, (j_) * GD_VB + GD_OFF_V); V.abk = L128(bc, (j_) * GD_VB + GD_OFF_S); } while (0)
#define GD_PIN(V) asm volatile("" : "+v"(V.k0), "+v"(V.k1), "+v"(V.k2), "+v"(V.k3), "+v"(V.q0), "+v"(V.q1), "+v"(V.q2), "+v"(V.q3), "+v"(V.vv), "+v"(V.abk), \
    "+v"(S2[0]), "+v"(S2[1]), "+v"(S2[2]), "+v"(S2[3]), "+v"(S2[4]), "+v"(S2[5]), "+v"(S2[6]), "+v"(S2[7]))
#define GD_STEP(V, j_) do { \
    f32x2 dk = S2[0] * V.k0.xy; dk += S2[1] * V.k0.zw; dk += S2[2] * V.k1.xy; dk += S2[3] * V.k1.zw; \
    dk += S2[4] * V.k2.xy; dk += S2[5] * V.k2.zw; dk += S2[6] * V.k3.xy; dk += S2[7] * V.k3.zw; \
    f32x2 dq_ = S2[0] * V.q0.xy; dq_ += S2[1] * V.q0.zw; dq_ += S2[2] * V.q1.xy; dq_ += S2[3] * V.q1.zw; \
    dq_ += S2[4] * V.q2.xy; dq_ += S2[5] * V.q2.zw; dq_ += S2[6] * V.q3.xy; dq_ += S2[7] * V.q3.zw; \
    float ks = red8(dk.x + dk.y), qs = red8(dq_.x + dq_.y);     \
    alpha *= V.abk.x;                                              \
    float cf = V.abk.y * (V.vv - alpha * ks); \
    float coef = cf * __builtin_amdgcn_rcpf(alpha); \
    S2[0] += V.k0.xy * coef; S2[1] += V.k0.zw * coef; S2[2] += V.k1.xy * coef; S2[3] += V.k1.zw * coef; \
    S2[4] += V.k2.xy * coef; S2[5] += V.k2.zw * coef; S2[6] += V.k3.xy * coef; S2[7] += V.k3.zw * coef; \
    float o_ = alpha * qs + cf * V.abk.z; ykeep = (dq == (j_)) ? o_ : ykeep; \
    if (((j_) & 3) == 3) { \
      S2[0] *= alpha; S2[1] *= alpha; S2[2] *= alpha; S2[3] *= alpha; S2[4] *= alpha; S2[5] *= alpha; S2[6] *= alpha; S2[7] *= alpha; alpha = 1.f; } \
    } while (0)
#define GD_2(jA, jB) GD_LDV(B, jA + 1); __builtin_amdgcn_sched_barrier(0); GD_STEP(A, jA); GD_PIN(B); \
                     GD_LDV(A, jB + 1); __builtin_amdgcn_sched_barrier(0); GD_STEP(B, jB); GD_PIN(A);
  gd_load<TPW>(p, b, h, qc0, vc, dir, 0, wv, R);
  GD_PREP(0);
  gd_load<TPW>(p, b, h, qc0, vc, dir, 1, wv, R);
  LBAR();
  for (int g = 0; g < NCHK; ++g) {
    LAS char* vbuf = lds + (g & 1) * TC * GD_VB;
    LAS float* obuf = (LAS float*)(lds + GD_OFF_Y + (g & 1) * TC * NCOL * 4);
    {
      GdVec A, B;
      LAS char* bk = vbuf + dq * 64 + (dq >> 2) * 16; LAS char* bv = vbuf + col * 4; LAS char* bc = vbuf;
      GD_LDV(A, 0); GD_PIN(A);
#pragma unroll 1
      for (int s8 = 0; s8 < TC; s8 += 8) {
        float ykeep = 0.f;
        GD_2(0, 1) GD_2(2, 3) GD_2(4, 5) GD_2(6, 7)
        obuf[(s8 + dq) * NCOL + col] = ykeep;
        bk += 8 * GD_VB; bv += 8 * GD_VB; bc += 8 * GD_VB;
      }
    }
    if (g + 1 < NCHK) GD_PREP(g + 1);
    if (g + 2 < NCHK) gd_load<TPW>(p, b, h, qc0, vc, dir, g + 2, wv, R);
    LBAR();
    {
      int seq, T, c0; chunk_pos(g, seq, T, c0);
      if (!(l == 1 && seq == 0))
#pragma unroll
      for (int q = 0; q < TC * NCOL / NTH; ++q) {
        int e = tl + q * NTH;
        int si = e / NCOL, cc = e % NCOL, s = c0 + si, t = dir ? T - 1 - s : s;
        oo[(unsigned)(tokrow(seq, b, t) * 512) + vcol + cc] = f2bf(obuf[e]);
      }
    }
  }
#undef GD_PREP
#undef GD_LDV
#undef GD_PIN
#undef GD_STEP
#undef GD_2
}

constexpr int MIX_GDN_LDS = 2 * TC * (276 + 32) * 4 + 2 * TC * 32 * 4;
constexpr int MIX_GLA_LDS = 2 * TC * (196 + 32) * 4 + 2 * TC * 32 * 4;
constexpr int LDS_TOTAL = MIX_GDN_LDS + MIX_GLA_LDS + 16;
__device__ void phase_scan(const P& p, int l, LAS char* lds) {
  for (int w = blockIdx.x; w < 256; w += gridDim.x) {
    const int x = w & 7, j = w >> 3;
    if ((x & 1) == 0) {
      int u = (x >> 1) * 32 + j;
      scan_rwkv(p, l, u >> 5, (u >> 2) & 7, (u >> 1) & 1, u & 1, lds);
    } else {
      const int m = (x >> 1) * 32 + j;
      const int wid = __builtin_amdgcn_readfirstlane(TIDX() >> 6);
      if (wid < 4) scan_gdn<4>(p, l, m >> 5, (m >> 3) & 3, (m >> 2) & 1, m & 3, lds);
      else scan_gla<4>(p, l, m >> 5, (m >> 3) & 3, (m >> 2) & 1, m & 3, lds + MIX_GDN_LDS);
    }
    __syncthreads();
  }
}

__device__ void phase_gdnprep(const P& p, int l, float* lds) {
  const int tid = TIDX(), lane = tid & 63, wv = tid >> 6;
  const float* cw = p.gdn_conv + (size_t)l * 3 * 1536;
  const int nw = gridDim.x * 8;
  float* aup_s = lds;
  for (int e = tid; e < 2 * 16 * 256; e += NTHR) aup_s[e] = p.gla_a_up[(size_t)l * 2 * 16 * 256 + e];
  float4 abias[2];
  abias[0] = *reinterpret_cast<const float4*>(p.gla_a_b + ((size_t)l * 2 + 0) * 256 + lane * 4);
  abias[1] = *reinterpret_cast<const float4*>(p.gla_a_b + ((size_t)l * 2 + 1) * 256 + lane * 4);
  const float gA = __expf(p.gdn_a_log[(size_t)l * 8 + (lane & 7)]), gdt = p.gdn_dt_bias[(size_t)l * 8 + (lane & 7)];
  __syncthreads();
  {
    float* tw_s = lds + 2 * 16 * 256 + 3 * 1536;
    const int fr = lane & 15, fq = lane >> 4;
#pragma unroll 1
    for (int dir = 0; dir < 2; ++dir) {
      float bw[8][4], ba[8][4], w0v[4], a0v[4];
#pragma unroll
      for (int nt = 0; nt < 4; ++nt) {
        const int chn = wv * 64 + nt * 16 + fr;
        w0v[nt] = p.rw_w0[((size_t)l * 2 + dir) * 512 + chn]; a0v[nt] = p.rw_a0[((size_t)l * 2 + dir) * 512 + chn];
#pragma unroll
        for (int k4 = 0; k4 < 8; ++k4) {
          bw[k4][nt] = p.rw_w2[(((size_t)l * 2 + dir) * 32 + k4 * 4 + fq) * 512 + chn];
          ba[k4][nt] = p.rw_a2[(((size_t)l * 2 + dir) * 32 + k4 * 4 + fq) * 512 + chn];
        }
      }
      const float mu_wa = p.rw_mu_wa[((size_t)l * 2 + dir) * 64 + lane];
      float* dD = p.rwd + (size_t)dir * NT * 512;
      float* dA = p.rwa + (size_t)dir * NT * 512;
      unsigned nwc[2], nwp[2];
#define RWP_LOAD(tile_) do { const int R0_ = (tile_) * 16; const int sq_ = R0_ < NX ? 1 : 0, T_ = sq_ ? SEQ : CTX; \
        const int tq0_ = (sq_ ? R0_ : R0_ - NX) & (T_ - 1); \
        _Pragma("unroll") for (int q = 0; q < 2; ++q) { const int tk = wv + 8 * q, t = tq0_ + tk, tp = dir ? t + 1 : t - 1; \
          const bool hp = tp >= 0 && tp < T_; const u16* pr = p.projb + (size_t)(R0_ + tk) * PROJP + O_RWA + lane; \
          nwc[q] = pr[0]; nwp[q] = pr[hp ? (dir ? PROJP : -PROJP) : 0]; } } while (0)
      if ((int)blockIdx.x < NT / 16) RWP_LOAD(blockIdx.x);
#pragma unroll 1
      for (int tile = blockIdx.x; tile < NT / 16; tile += gridDim.x) {
        const int R0 = tile * 16;
        const int sq = R0 < NX ? 1 : 0, T = sq ? SEQ : CTX;
        const int tq0 = (sq ? R0 : R0 - NX) & (T - 1);
#pragma unroll
        for (int q = 0; q < 2; ++q) {
          const int tk = wv + 8 * q, t = tq0 + tk, tp = dir ? t + 1 : t - 1;
          const bool hp = tp >= 0 && tp < T;
          float wc = bf2f((u16)nwc[q]);
          float wp = hp ? bf2f((u16)nwp[q]) : 0.f;
          float xwa = wc + (wp - wc) * mu_wa;
          tw_s[tk * 68 + lane] = lane < 32 ? tanhf_(xwa) : xwa;
        }
        if (tile + (int)gridDim.x < NT / 16) RWP_LOAD(tile + gridDim.x);
        LBAR();
        float aw[8], aa[8];
#pragma unroll
        for (int k4 = 0; k4 < 8; ++k4) { aw[k4] = tw_s[fr * 68 + k4 * 4 + fq]; aa[k4] = tw_s[fr * 68 + 32 + k4 * 4 + fq]; }
#pragma unroll
        for (int nt = 0; nt < 4; ++nt) {
          f32x4 cw = (f32x4){0.f, 0.f, 0.f, 0.f}, ca = cw;
#pragma unroll
          for (int k4 = 0; k4 < 8; ++k4) {
            cw = __builtin_amdgcn_mfma_f32_16x16x4f32(aw[k4], bw[k4][nt], cw, 0, 0, 0);
            ca = __builtin_amdgcn_mfma_f32_16x16x4f32(aa[k4], ba[k4][nt], ca, 0, 0, 0);
          }
#pragma unroll
          for (int j = 0; j < 4; ++j) {
            const size_t o = (size_t)(R0 + fq * 4 + j) * 512 + wv * 64 + nt * 16 + fr;
            dD[o] = __expf(-0.6065306597126334f * sigmoidf_(w0v[nt] + cw[j]));
            dA[o] = sigmoidf_(a0v[nt] + ca[j]);
          }
        }
        LBAR();
      }
    }
  }
  for (int row = blockIdx.x * 8 + wv; row < NT; row += nw) {
    const int seq = row < NX ? 1 : 0;
    const int RL = seq ? 64 : 256;
    const int t = (seq ? row : row - NX) & (RL - 1);
    const float ml = t != 0 ? 1.f : 0.f, mr = t != RL - 1 ? 1.f : 0.f;
    const u16* pc = p.projb + (size_t)row * PROJP + O_DQKV;
    const u16* pl = pc - (t != 0 ? PROJP : 0);
    const u16* pn = pc + (t != RL - 1 ? PROJP : 0);
    float x[24];
    unsigned rc[24], rl[24], rr[24];
#pragma unroll
    for (int j = 0; j < 24; ++j) { const int c = j * 64 + lane; rc[j] = pc[c]; rl[j] = pl[c]; rr[j] = pn[c]; }
    unsigned glo_raw = p.projb[(size_t)row * PROJP + O_GLO + (lane & 15)], dab_raw = p.projb[(size_t)row * PROJP + O_DA + (lane & 15)];
    unsigned glq[4], glk[4];
#pragma unroll
    for (int j = 0; j < 4; ++j) { glq[j] = p.projb[(size_t)row * PROJP + O_GQ + j * 64 + lane]; glk[j] = p.projb[(size_t)row * PROJP + O_GK + j * 64 + lane]; }
    asm volatile("" : "+v"(glo_raw), "+v"(dab_raw), "+v"(glq[0]), "+v"(glq[1]), "+v"(glq[2]), "+v"(glq[3]), "+v"(glk[0]), "+v"(glk[1]), "+v"(glk[2]), "+v"(glk[3]));
#define PIN8(a, o) asm volatile("" : "+v"(a[o]), "+v"(a[o + 1]), "+v"(a[o + 2]), "+v"(a[o + 3]), "+v"(a[o + 4]), "+v"(a[o + 5]), "+v"(a[o + 6]), "+v"(a[o + 7]))
    PIN8(rc, 0); PIN8(rc, 8); PIN8(rc, 16); PIN8(rl, 0); PIN8(rl, 8); PIN8(rl, 16); PIN8(rr, 0); PIN8(rr, 8); PIN8(rr, 16);
#pragma unroll
    for (int g8 = 0; g8 < 3; ++g8) {
      float w0[8], w1[8], w2[8];
      const float* cwl = cw; asm volatile("" : "+s"(cwl));
#pragma unroll
      for (int j = 0; j < 8; ++j) { const int c = (g8 * 8 + j) * 64 + lane; w0[j] = cwl[c]; w1[j] = cwl[1536 + c]; w2[j] = cwl[3072 + c]; }
      PIN8(w0, 0); PIN8(w1, 0); PIN8(w2, 0);
#pragma unroll
      for (int j = 0; j < 8; ++j) {
        float xc = bf2f((u16)rc[g8 * 8 + j]), xl = bf2f((u16)rl[g8 * 8 + j]) * ml, xr = bf2f((u16)rr[g8 * 8 + j]) * mr;
        x[g8 * 8 + j] = siluf_(xl * w0[j] + xc * w1[j] + xr * w2[j]);
      }
    }
#undef PIN8
    {
      float glo = bf2f((u16)glo_raw);
      float dab = bf2f((u16)dab_raw);
#pragma unroll
      for (int dir = 0; dir < 2; ++dir) {
        float4 acc = abias[dir];
#pragma unroll
        for (int m = 0; m < 16; ++m) {
          float g = rdlane(glo, m);
          float4 w = *reinterpret_cast<const float4*>(aup_s + (dir * 16 + m) * 256 + lane * 4);
          acc.x += g * w.x; acc.y += g * w.y; acc.z += g * w.z; acc.w += g * w.w;
        }
        float4 f;
        f.x = __expf((fminf(acc.x, 0.f) - __logf(1.f + __expf(-fabsf(acc.x)))) * (1.f / 16.f));
        f.y = __expf((fminf(acc.y, 0.f) - __logf(1.f + __expf(-fabsf(acc.y)))) * (1.f / 16.f));
        f.z = __expf((fminf(acc.z, 0.f) - __logf(1.f + __expf(-fabsf(acc.z)))) * (1.f / 16.f));
        f.w = __expf((fminf(acc.w, 0.f) - __logf(1.f + __expf(-fabsf(acc.w)))) * (1.f / 16.f));
        *reinterpret_cast<float4*>(p.glf + ((size_t)dir * NT + row) * 256 + lane * 4) = f;
      }
      float db_v = __shfl(dab, (lane & 7) + 8);
      float a_v = fmaxf(__expf(-gA * softplusf_(dab + gdt)), 1e-9f);
      float b_v = sigmoidf_(db_v);
      if (lane < 8) *reinterpret_cast<float2*>(p.gab + (((size_t)(lane >> 2) * NT + row) * 4 + (lane & 3)) * 2) = make_float2(a_v, b_v);
    }
    u16* dst = p.nbuf + (size_t)row * D;
#pragma unroll
    for (int hh = 0; hh < 4; ++hh) {
      float qs = wave_sum_b(x[2 * hh] * x[2 * hh] + x[2 * hh + 1] * x[2 * hh + 1]);
      float ks = wave_sum_b(x[8 + 2 * hh] * x[8 + 2 * hh] + x[8 + 2 * hh + 1] * x[8 + 2 * hh + 1]);
      float qn = rsqrtf(qs + 1e-6f) * 0.08838834764831845f, kn = rsqrtf(ks + 1e-6f);
      u16 q0b = f2bf(x[2 * hh] * qn), q1b = f2bf(x[2 * hh + 1] * qn), k0b = f2bf(x[8 + 2 * hh] * kn), k1b = f2bf(x[8 + 2 * hh + 1] * kn);
      float kqd = wave_sum_b(bf2f(k0b) * bf2f(q0b) + bf2f(k1b) * bf2f(q1b));
      float kql = wave_sum_b(bf2f((u16)glq[hh]) * 0.125f * bf2f((u16)glk[hh]));
      if (lane == 0) { p.kqa[(size_t)row * 8 + hh] = kqd; p.kqa[(size_t)row * 8 + 4 + hh] = kql; }
      dst[(2 * hh) * 64 + lane] = q0b; dst[(2 * hh + 1) * 64 + lane] = q1b;
      dst[512 + (2 * hh) * 64 + lane] = k0b; dst[512 + (2 * hh + 1) * 64 + lane] = k1b;
      dst[1024 + (2 * hh) * 64 + lane] = f2bf(x[16 + 2 * hh]); dst[1024 + (2 * hh + 1) * 64 + lane] = f2bf(x[16 + 2 * hh + 1]);
    }
  }
}

__device__ void phase_combine(const P& p, int l, int ntok, float* lds) {
  float* sig = lds;
  const int tid = TIDX(), lane = tid & 63, wv = tid >> 6;
  const float* g2 = p.rw_g2 + (size_t)l * 96 * 512;
  float g2r[96];
#pragma unroll
  for (int m = 0; m < 96; ++m) g2r[m] = g2[m * 512 + tid];
  const float gnw = p.rw_gn_w[(size_t)l * 512 + tid], gnb = p.rw_gn_b[(size_t)l * 512 + tid];
  const float muvf = p.rw_mu_rkv[((size_t)l * 2 + 0) * 1536 + 1024 + tid];
  const float muvb = p.rw_mu_rkv[((size_t)l * 2 + 1) * 1536 + 1024 + tid];
  const float scw0 = p.sc_conv[(size_t)l * 1536 + tid], scw1 = p.sc_conv[(size_t)l * 1536 + 512 + tid],
              scw2 = p.sc_conv[(size_t)l * 1536 + 1024 + tid];
  const int mixer = wv >> 2, hh = wv & 3;
  const float* ng = (mixer == 0 ? p.gla_norm_g : p.gdn_norm_g) + (size_t)l * 128;
  const float ng0 = ng[lane], ng1 = ng[lane + 64];
  const u16* om0 = osc_ptr(p, mixer, 0);
  const u16* om1 = osc_ptr(p, mixer, 1);
  const u16* or0 = osc_ptr(p, 2, 0);
  const u16* or1 = osc_ptr(p, 2, 1);
  const int gch = (mixer == 0 ? O_GR : O_DZ) + hh * 128 + lane;
  for (int tile = blockIdx.x; tile < ntok / 16; tile += gridDim.x) {
    const int r0 = tile * 16;
    const int seq = r0 < NX ? 1 : 0;
    const int T = seq ? SEQ : CTX, RL = seq ? 64 : 256;
    const int tb = (seq ? r0 : r0 - NX) & (T - 1);
    __syncthreads();
    for (int e = tid; e < 16 * 96; e += NTHR) {
      int i = e / 96, m = e % 96;
      sig[e] = sigmoidf_(bf2f(p.projb[(size_t)(r0 + i) * PROJP + O_RG + m]));
    }
    __syncthreads();
#define PIN8(a) asm volatile("" : "+v"(a[0]), "+v"(a[1]), "+v"(a[2]), "+v"(a[3]))
#pragma unroll 1
    for (int i0 = 0; i0 < 16; i0 += 4) {
      float sf[4], sb[4];
      unsigned y0[4], y1[4], a0[4], a1[4], a2[4], a3[4], vc[4], vp[4], vn[4], g0r[4], g1r[4], cbr[4], ucc[6], uch[6];
#pragma unroll
      for (int i = 0; i < 4; ++i) {
        int row = r0 + i0 + i, t = tb + i0 + i;
        y0[i] = or0[(size_t)row * 512 + tid]; y1[i] = or1[(size_t)row * 512 + tid];
        const u16* pv = p.projb + (size_t)row * PROJP + O_RKV + 1024 + tid;
        vc[i] = pv[0]; vp[i] = pv[t > 0 ? -PROJP : 0]; vn[i] = pv[t < T - 1 ? PROJP : 0];
        sf[i] = p.sbon[(size_t)row * 8 + wv]; sb[i] = p.sbon[(size_t)NT * 8 + (size_t)row * 8 + wv];
        size_t ob = (size_t)row * 512 + hh * 128 + lane;
        a0[i] = om0[ob]; a1[i] = om1[ob]; a2[i] = om0[ob + 64]; a3[i] = om1[ob + 64];
        const u16* pg = p.projb + (size_t)row * PROJP + gch;
        g0r[i] = pg[0]; g1r[i] = pg[64];
        cbr[i] = p.projb[(size_t)row * PROJP + O_CB + tid];
      }
      {
        const u16* pc = p.projb + (size_t)(r0 + i0) * PROJP;
#pragma unroll
        for (int j = 0; j < 6; ++j) {
          int t = tb + i0 + j - 1;
          int off = (t < 0 ? 0 : (t > T - 1 ? T - 1 : t)) - (tb + i0);
          const u16* pr = pc + (long)off * PROJP;
          ucc[j] = pr[O_CC + tid]; uch[j] = pr[O_CH + tid];
        }
      }
      PIN8(y0); PIN8(y1); PIN8(sf); PIN8(sb); PIN8(a0); PIN8(a1); PIN8(a2); PIN8(a3);
      PIN8(vc); PIN8(vp); PIN8(vn); PIN8(g0r); PIN8(g1r); PIN8(cbr); PIN8(ucc); PIN8(uch);
      asm volatile("" : "+v"(ucc[4]), "+v"(ucc[5]), "+v"(uch[4]), "+v"(uch[5]));
      {
        float gate[4];
#pragma unroll
        for (int i = 0; i < 4; ++i) gate[i] = 0.f;
#pragma unroll
        for (int m = 0; m < 96; m += 4) {
#pragma unroll
          for (int i = 0; i < 4; ++i) {
            float4 s = *reinterpret_cast<const float4*>(sig + (i0 + i) * 96 + m);
            gate[i] += s.x * g2r[m] + s.y * g2r[m + 1] + s.z * g2r[m + 2] + s.w * g2r[m + 3];
          }
        }
#pragma unroll
        for (int i = 0; i < 4; ++i) {
          int row = r0 + i0 + i, t = tb + i0 + i;
          float yv = bf2f((u16)y0[i]) + bf2f((u16)y1[i]);
          float mean = wave_sum_b(yv) * (1.f / 64.f);
          float d = yv - mean;
          float var = wave_sum_b(d * d) * (1.f / 64.f);
          float yn = d * rsqrtf(var + 64e-5f) * gnw + gnb;
          float v_c = bf2f((u16)vc[i]), v_p = t > 0 ? bf2f((u16)vp[i]) : 0.f, v_n = t < T - 1 ? bf2f((u16)vn[i]) : 0.f;
          float vf = v_c + (v_p - v_c) * muvf, vb = v_c + (v_n - v_c) * muvb;
          float bonus = sf[i] * vf + sb[i] * vb;
          p.nbuf[(size_t)row * D + 1536 + tid] = f2bf((yn + bonus) * gate[i]);
        }
      }
#pragma unroll
      for (int i = 0; i < 4; ++i) {
        int row = r0 + i0 + i;
        float o0 = bf2f((u16)a0[i]) + bf2f((u16)a1[i]), o1 = bf2f((u16)a2[i]) + bf2f((u16)a3[i]);
        float ss = wave_sum_b(o0 * o0 + o1 * o1);
        float rstd = rsqrtf(ss * (1.f / 128.f) + 1e-6f);
        u16* dst = p.nbuf + (size_t)row * D + mixer * 512 + hh * 128 + lane;
        dst[0] = f2bf(o0 * rstd * ng0 * siluf_(bf2f((u16)g0r[i])));
        dst[64] = f2bf(o1 * rstd * ng1 * siluf_(bf2f((u16)g1r[i])));
      }
#pragma unroll
      for (int i = 0; i < 4; ++i) {
        int tr = (tb + i0 + i) & (RL - 1);
        float up = tr != 0 ? bf2f((u16)ucc[i]) * bf2f((u16)uch[i]) : 0.f;
        float uc = bf2f((u16)ucc[i + 1]) * bf2f((u16)uch[i + 1]);
        float un = tr != RL - 1 ? bf2f((u16)ucc[i + 2]) * bf2f((u16)uch[i + 2]) : 0.f;
        float cv = scw0 * up + scw1 * uc + scw2 * un;
        p.nbuf[(size_t)(r0 + i0 + i) * D + 1024 + tid] = f2bf(bf2f((u16)cbr[i]) * cv);
      }
    }
#undef PIN8
  }
}

#define XB_TMO      128
#define XB_XCNT(j)  (256  + 64 * (j))
#define XB_XSUB(j)  (1280 + 64 * (j))
#define XB_XGEN(j)  (2304 + 64 * (j))
#define XB_TOP      3328
#define XB_TOPGEN   3392
#define XCD_BAR_WORDS 3456
#define XB_SPIN_CAP (1u << 18)
__device__ __forceinline__ unsigned xb_ld(unsigned* p) { return __hip_atomic_load(p, __ATOMIC_RELAXED, __HIP_MEMORY_SCOPE_AGENT); }
__device__ __forceinline__ unsigned xb_add(unsigned* p, unsigned v) { return __hip_atomic_fetch_add(p, v, __ATOMIC_RELAXED, __HIP_MEMORY_SCOPE_AGENT); }
__device__ __forceinline__ unsigned xb_xcc_id() { return (unsigned)__builtin_amdgcn_s_getreg((3 << 11) | 20) & 0xFu; }
#define XB_SPIN(cond, bar) do { unsigned _sp = 0; while (cond) { __builtin_amdgcn_s_sleep(1); \
    if ((++_sp & 255u) == 0u) { if (xb_ld(&(bar)[XB_TMO])) break; if (_sp > XB_SPIN_CAP) { atomicAdd(&(bar)[XB_TMO], 1u); break; } } } } while (0)
struct XcdBarrier { unsigned* bar; unsigned x; volatile LAS unsigned* st; };
__device__ __forceinline__ XcdBarrier xcd_barrier_post(unsigned* bar, volatile LAS unsigned* st) {
  XcdBarrier b; b.bar = bar; b.x = xb_xcc_id(); b.st = st;
  if (threadIdx.x == 0) (void)xb_add(&bar[XB_XCNT(b.x)], 1u);
  return b;
}
__device__ __forceinline__ void xcd_barrier_complete(unsigned* bar, unsigned x, unsigned& nloc, unsigned& nx) {
  const unsigned G = gridDim.x * gridDim.y * gridDim.z;
  unsigned sum, cnt, mine, sp = 0u;
  for (;;) {
    sum = 0u; cnt = 0u; mine = 0u;
#pragma unroll
    for (unsigned j = 0; j < 16; ++j) { const unsigned c = xb_ld(&bar[XB_XCNT(j)]); sum += c; cnt += (c > 0u) ? 1u : 0u; mine = (j == x) ? c : mine; }
    if (sum == G) break;
    __builtin_amdgcn_s_sleep(1);
    if ((++sp & 255u) == 0u) { if (xb_ld(&bar[XB_TMO])) break; if (sp > XB_SPIN_CAP) { atomicAdd(&bar[XB_TMO], 1u); break; } }
  }
  nloc = mine > 0u ? mine : 1u; nx = cnt > 0u ? cnt : 1u;
}
__device__ __forceinline__ void xcd_barrier(const XcdBarrier& b) {
  asm volatile("s_waitcnt vmcnt(0)" ::: "memory");
  __syncthreads();
  if (threadIdx.x == 0) {
    unsigned* bar = b.bar;
    __builtin_amdgcn_s_waitcnt(0);
    unsigned nloc = b.st[0], nx = b.st[1];
    if (nloc == 0u) { xcd_barrier_complete(bar, b.x, nloc, nx); b.st[0] = nloc; b.st[1] = nx; }
    const unsigned old = xb_add(&bar[XB_XSUB(b.x)], 1u);
    const unsigned gen = old / nloc;
    if (old + 1u == (gen + 1u) * nloc) {
      __builtin_amdgcn_fence(__ATOMIC_RELEASE, "agent");
      asm volatile("s_waitcnt vmcnt(0)" ::: "memory");
      const unsigned og = xb_add(&bar[XB_TOP], 1u);
      const unsigned tg = og / nx;
      if (og + 1u == (tg + 1u) * nx) xb_add(&bar[XB_TOPGEN], 1u);
      else XB_SPIN(xb_ld(&bar[XB_TOPGEN]) == tg, bar);
      __builtin_amdgcn_fence(__ATOMIC_ACQUIRE, "agent");
      xb_add(&bar[XB_XGEN(b.x)], 1u);
      asm volatile("s_waitcnt vmcnt(0)" ::: "memory");
    } else {
      XB_SPIN(xb_ld(&bar[XB_XGEN(b.x)]) == gen, bar);
      __builtin_amdgcn_fence(__ATOMIC_ACQUIRE, "agent");
      asm volatile("s_waitcnt vmcnt(0)" ::: "memory");
    }
  }
  __syncthreads();
}

constexpr int NPH = 20;
__device__ void run_phase(const P& p, int ph, char* shm) {
  float* lf = reinterpret_cast<float*>(shm);
  LAS unsigned char* ll = (LAS unsigned char*)shm;
  if (ph == 0) { phase_mod(p, lf); __syncthreads(); phase_convert(p, 0, lf, blockIdx.x, gridDim.x); return; }
  if (ph == 19) { phase_norm(p, 1, 2, NX); return; }
  const int l = (ph - 1) / 9, s = (ph - 1) % 9;
  const int mtok = (l == 1) ? NX : NT;
  switch (s) {
    case 0: if (l > 0) phase_convert(p, l, lf, blockIdx.x, gridDim.x); phase_norm(p, l, 0, NT); break;
    case 1: { EpiProj E{p.projb}; gemm_phase(ll, p.nbuf, p.wt_in, NT, PROJP, D, E); } break;
    case 2: phase_gdnprep(p, l, lf); break;
    case 3: phase_scan(p, l, (LAS char*)shm); break;
    case 4: phase_combine(p, l, mtok, lf); break;
    case 5: { EpiRes E{l == 0 ? p.x : nullptr, l == 0 ? p.ctx : nullptr, p.out, p.hc, p.mod + (size_t)l * 5 * 6 * D + 2 * D};
              gemm_phase(ll, p.nbuf, p.wt_out, mtok, D, D, E); } break;
    case 6: phase_norm(p, l, 1, mtok); break;
    case 7: { EpiGU E{p.projb}; gemm_phase(ll, p.nbuf, p.wt_gu, mtok, 2 * FFN, D, E); } break;
    case 8: { EpiRes E{nullptr, nullptr, p.out, p.hc, p.mod + (size_t)l * 5 * 6 * D + 5 * D};
              gemm_phase(ll, p.projb, p.wt_down, mtok, D, FFN, E); } break;
  }
}

__global__ void __launch_bounds__(NTHR, 2) mega(P p, int ph0, int ph1) {
  extern __shared__ __attribute__((aligned(16))) char shm[];
  volatile LAS unsigned* xst = (volatile LAS unsigned*)((LAS char*)shm + LDS_TOTAL - 16);
  if (threadIdx.x < 4) xst[threadIdx.x] = 0u;
  __syncthreads();
  XcdBarrier xb = xcd_barrier_post(p.bar, xst);
  for (int ph = ph0; ph < ph1; ++ph) {
    int nrep = 1;
#ifdef DUPMASK
    if ((DUPMASK >> ph) & 1) nrep = 2;
#endif
#pragma unroll 1
    for (int rep = 0; rep < nrep; ++rep) {
      run_phase(p, ph, shm);
      if (rep + 1 < nrep) xcd_barrier(xb);
    }
    if (ph + 1 < ph1) {
      if (ph == ph0) cg::this_grid().sync(); else xcd_barrier(xb);
    }
#ifdef PROBE_XSYNC
    if (ph == 5) { for (int q = 0; q < 20; ++q) xcd_barrier(xb); }
#endif
  }
}

extern "C" void kernel_launch(void* const* d_in, const int* in_sizes, int n_in, void* d_out, int out_size, void* d_ws,
                              size_t ws_size, hipStream_t stream) {
  P p{};
  const float** pf = reinterpret_cast<const float**>(&p);
  for (int i = 0; i < 33; ++i) pf[i] = (const float*)d_in[i];
  p.out = (float*)d_out;
  char* w = (char*)d_ws;
  size_t off = 0;
  auto take = [&](size_t bytes) { char* r = w + off; off += (bytes + 255) & ~(size_t)255; return r; };
  p.wt_in = (u16*)take((size_t)PROJP * D * 2);
  p.wt_out = (u16*)take((size_t)D * D * 2);
  p.wt_gu = (u16*)take((size_t)2 * FFN * D * 2);
  p.wt_down = (u16*)take((size_t)D * FFN * 2);
  p.nbuf = (u16*)take((size_t)NT * D * 2);
  p.projb = (u16*)take((size_t)NT * PROJP * 2);
  p.mod = (float*)take((size_t)2 * 5 * 6 * D * 4);
  p.hc = (float*)take((size_t)NC * D * 4);
  p.osc = (float*)take((size_t)6 * NT * 512 * 2);
  p.sbon = (float*)take((size_t)2 * NT * 8 * 4);
  p.bar = (unsigned*)take((size_t)XCD_BAR_WORDS * 4);
  p.rwd = (float*)take((size_t)2 * NT * 512 * 4);
  p.rwa = (float*)take((size_t)2 * NT * 512 * 4);
  p.kqa = (float*)take((size_t)NT * 8 * 4);
  p.glf = (float*)take((size_t)2 * NT * 256 * 4);
  p.gab = (float*)take((size_t)2 * NT * 8 * 4);
  static int grid_blocks = 0;
  if (!grid_blocks) {
    hipFuncSetAttribute((const void*)mega, hipFuncAttributeMaxDynamicSharedMemorySize, LDS_TOTAL);
    int dev = 0, cus = 0, per_cu = 0;
    hipGetDevice(&dev);
    hipDeviceGetAttribute(&cus, hipDeviceAttributeMultiprocessorCount, dev);
    hipOccupancyMaxActiveBlocksPerMultiprocessor(&per_cu, mega, NTHR, LDS_TOTAL);
    if (per_cu < 1) per_cu = 1;
    grid_blocks = cus * 1;
  }
  hipMemsetAsync(p.bar, 0, (size_t)XCD_BAR_WORDS * 4, stream);
#if MEGA
  int ph0 = 0, ph1 = NPH;
  void* args[] = {&p, &ph0, &ph1};
  hipError_t e = hipLaunchCooperativeKernel((void*)mega, dim3(grid_blocks), dim3(NTHR), args, LDS_TOTAL, stream);
  if (e != hipSuccess) fprintf(stderr, "cooperative launch failed: %s (grid %d)\n", hipGetErrorString(e), grid_blocks);
#else
  for (int ph = 0; ph < NPH; ++ph) mega<<<grid_blocks, NTHR, LDS_TOTAL, stream>>>(p, ph, ph + 1);
#endif
}
```
